# Optimizing an MI355X kernel written in HIP

```python
import jax, jax.numpy as jnp
from jax import lax
import numpy as np

D_MODEL = 1024
BATCH = 2
SEQ = 8192
DEPTH = 4

CHUNK = 64
HEAD_DIM = 64
N_FOX_HEADS = D_MODEL // (2 * HEAD_DIM)
N_SB_HEADS = D_MODEL // (2 * HEAD_DIM)
N_HEADS = N_FOX_HEADS + N_SB_HEADS
D_FOX = N_FOX_HEADS * HEAD_DIM
D_SB = N_SB_HEADS * HEAD_DIM
D_MIX = D_FOX + D_SB
QBLOCK = 128
N_EXPERTS = 16
N_GROUPS = 4
EXPERTS_PER_GROUP = N_EXPERTS // N_GROUPS
TOP_K = 2
D_EXPERT = D_MODEL
EXPERT_BLOCK = 128
DEEPNORM_ALPHA = (2 * DEPTH) ** 0.25
DEEPNORM_BETA = (8 * DEPTH) ** -0.25
LN_EPS = 1e-5
RMS_EPS = 1e-6
N_MOD = 6
SPLIT_POINTS = (D_FOX, 2 * D_FOX, 3 * D_FOX, 4 * D_FOX, 4 * D_FOX + N_FOX_HEADS,
                4 * D_FOX + N_FOX_HEADS + D_SB, 4 * D_FOX + N_FOX_HEADS + 2 * D_SB)
N_IN = 4 * D_FOX + N_FOX_HEADS + 3 * D_SB

kernel_name = "hybrid_fox_stickbreak_grouped_moe_deepnorm"


def layer_norm(x, g, b):
    xf = x.astype(jnp.float32)
    mu = jnp.mean(xf, axis=-1, keepdims=True)
    var = jnp.mean(jnp.square(xf - mu), axis=-1, keepdims=True)
    return ((xf - mu) * lax.rsqrt(var + LN_EPS) * g + b).astype(x.dtype)


def _split_heads(t, n_heads):
    B, S, _ = t.shape
    return t.reshape(B, S, n_heads, HEAD_DIM).transpose(0, 2, 1, 3)


def forgetting_attention(q, k, v, log_f):
    B, H, S, Dh = q.shape
    nb = S // QBLOCK
    F = jnp.cumsum(log_f, axis=-1)
    q_blocks = q.reshape(B, H, nb, QBLOCK, Dh).transpose(2, 0, 1, 3, 4)
    F_blocks = F.reshape(B, H, nb, QBLOCK).transpose(2, 0, 1, 3)
    k_pos = jnp.arange(S)
    scale = HEAD_DIM ** -0.5

    def block(args):
        qb, Fb, start = args
        logits = jnp.einsum('bhqd,bhkd->bhqk', qb, k).astype(jnp.float32) * scale
        logits = logits + (Fb[..., :, None] - F[:, :, None, :])
        q_pos = start + jnp.arange(QBLOCK)
        causal = k_pos[None, :] <= q_pos[:, None]
        logits = jnp.where(causal, logits, -jnp.inf)
        p = jax.nn.softmax(logits, axis=-1)
        return jnp.einsum('bhqk,bhkd->bhqd', p.astype(v.dtype), v)

    out = lax.map(block, (q_blocks, F_blocks, jnp.arange(nb) * QBLOCK))
    return out.transpose(1, 2, 0, 3, 4).reshape(B, H, S, Dh)


def stick_breaking_attention(q, k, v):
    B, H, S, Dh = q.shape
    nb = S // QBLOCK
    q_blocks = q.reshape(B, H, nb, QBLOCK, Dh).transpose(2, 0, 1, 3, 4)
    k_pos = jnp.arange(S)
    scale = HEAD_DIM ** -0.5

    def block(args):
        qb, start = args
        z = jnp.einsum('bhqd,bhkd->bhqk', qb, k).astype(jnp.float32) * scale
        q_pos = start + jnp.arange(QBLOCK)
        strict = k_pos[None, :] < q_pos[:, None]
        log_beta = jax.nn.log_sigmoid(z)
        log_keep = jnp.where(strict, jax.nn.log_sigmoid(-z), 0.0)
        later = lax.cumsum(log_keep, axis=3, reverse=True) - log_keep
        w = jnp.where(strict, jnp.exp(log_beta + later), 0.0)
        return jnp.einsum('bhqk,bhkd->bhqd', w.astype(v.dtype), v)

    out = lax.map(block, (q_blocks, jnp.arange(nb) * QBLOCK))
    return out.transpose(1, 2, 0, 3, 4).reshape(B, H, S, Dh)


def hybrid_mixer(u, w_in, b_forget, out_norm_g, w_out):
    B, S, _ = u.shape
    proj = u @ w_in
    fq, fk, fv, fgate, fforget, sq, sk, sv = jnp.split(proj, SPLIT_POINTS, axis=-1)
    log_f = jax.nn.log_sigmoid((fforget + b_forget).astype(jnp.float32)).transpose(0, 2, 1)
    o_fox = forgetting_attention(_split_heads(fq, N_FOX_HEADS), _split_heads(fk, N_FOX_HEADS),
                                 _split_heads(fv, N_FOX_HEADS), log_f)
    o_sb = stick_breaking_attention(_split_heads(sq, N_SB_HEADS), _split_heads(sk, N_SB_HEADS),
                                    _split_heads(sv, N_SB_HEADS))
    o = jnp.concatenate([o_fox, o_sb], axis=1).transpose(0, 2, 1, 3)
    of = o.astype(jnp.float32)
    of = of * lax.rsqrt(jnp.mean(jnp.square(of), axis=-1, keepdims=True) + RMS_EPS)
    o = (of * out_norm_g.reshape(N_HEADS, HEAD_DIM)).astype(u.dtype).reshape(B, S, D_MIX)
    o = jnp.concatenate([o[..., :D_FOX] * jax.nn.sigmoid(fgate), o[..., D_FOX:]], axis=-1)
    return o @ w_out


def grouped_moe(h, w_router, b_router, w_gate, w_up, w_down):
    T, D = h.shape
    probs = jax.nn.softmax((h @ w_router).astype(jnp.float32), axis=-1)
    sel = probs + b_router
    group_score = lax.top_k(sel.reshape(T, N_GROUPS, EXPERTS_PER_GROUP), TOP_K)[0].sum(-1)
    best_group = jnp.argmax(group_score, axis=-1)
    in_group = (jnp.arange(N_EXPERTS) // EXPERTS_PER_GROUP)[None, :] == best_group[:, None]
    _, expert_idx = lax.top_k(jnp.where(in_group, sel, -jnp.inf), TOP_K)
    gate_w = jnp.take_along_axis(probs, expert_idx, axis=-1)
    gate_w = gate_w / jnp.sum(gate_w, axis=-1, keepdims=True)

    A = T * TOP_K
    flat_e = expert_idx.reshape(-1)
    flat_tok = jnp.repeat(jnp.arange(T), TOP_K)
    flat_w = gate_w.reshape(-1)
    order = jnp.argsort(flat_e)
    sorted_e = flat_e[order]
    sorted_tok = flat_tok[order]
    sorted_w = flat_w[order]
    counts = jnp.bincount(flat_e, length=N_EXPERTS)
    padded = (counts + EXPERT_BLOCK - 1) // EXPERT_BLOCK * EXPERT_BLOCK
    starts = jnp.cumsum(counts) - counts
    pad_ends = jnp.cumsum(padded)
    pad_starts = pad_ends - padded
    dest = pad_starts[sorted_e] + (jnp.arange(A) - starts[sorted_e])
    n_blocks = A // EXPERT_BLOCK + N_EXPERTS
    P = n_blocks * EXPERT_BLOCK
    row_tok = jnp.zeros((P,), jnp.int32).at[dest].set(sorted_tok.astype(jnp.int32))
    block_e = jnp.minimum(jnp.searchsorted(pad_ends, jnp.arange(n_blocks) * EXPERT_BLOCK, side='right'),
                          N_EXPERTS - 1)
    xs = h[row_tok].reshape(n_blocks, EXPERT_BLOCK, D)

    def expert_block(args):
        xb, e = args
        return (jax.nn.silu(xb @ w_gate[e]) * (xb @ w_up[e])) @ w_down[e]

    yb = lax.map(expert_block, (xs, block_e)).reshape(P, D)
    y_assign = yb[dest] * sorted_w[:, None].astype(h.dtype)
    return jax.ops.segment_sum(y_assign, sorted_tok, num_segments=T)


def setup_inputs(seed: int = 0) -> dict:
    key = jax.random.key(seed)
    ks = jax.random.split(key, 18)
    f32 = jnp.float32
    nrm = lambda k, shape, s: jax.random.normal(k, shape, f32) * s
    col_scale = jnp.concatenate([jnp.ones((2 * D_FOX,), f32), jnp.full((D_FOX,), DEEPNORM_BETA, f32),
                                 jnp.ones((D_FOX + N_FOX_HEADS + 2 * D_SB,), f32),
                                 jnp.full((D_SB,), DEEPNORM_BETA, f32)])
    return {
        "x": nrm(ks[0], (BATCH, SEQ, D_MODEL), 1.0),
        "c": nrm(ks[1], (BATCH, D_MODEL), 1.0),
        "w_mod": nrm(ks[2], (DEPTH, D_MODEL, N_MOD * D_MODEL), 0.5 * D_MODEL ** -0.5),
        "b_mod": nrm(ks[3], (DEPTH, N_MOD * D_MODEL), 0.02),
        "w_in": nrm(ks[4], (DEPTH, D_MODEL, N_IN), D_MODEL ** -0.5) * col_scale,
        "b_forget": jax.random.uniform(ks[5], (DEPTH, N_FOX_HEADS), f32, 1.0, 5.0),
        "out_norm_g": 1.0 + nrm(ks[6], (DEPTH, D_MIX), 0.02),
        "w_out": nrm(ks[7], (DEPTH, D_MIX, D_MODEL), D_MIX ** -0.5 * DEEPNORM_BETA),
        "ln1_g": 1.0 + nrm(ks[8], (DEPTH, D_MODEL), 0.02),
        "ln1_b": nrm(ks[9], (DEPTH, D_MODEL), 0.02),
        "w_router": nrm(ks[10], (D_MODEL, N_EXPERTS), D_MODEL ** -0.5),
        "b_router": nrm(ks[11], (N_EXPERTS,), 0.01),
        "w_gate": nrm(ks[12], (DEPTH, N_EXPERTS, D_MODEL, D_EXPERT), D_MODEL ** -0.5),
        "w_up": nrm(ks[13], (DEPTH, N_EXPERTS, D_MODEL, D_EXPERT), D_MODEL ** -0.5 * DEEPNORM_BETA),
        "w_down": nrm(ks[14], (DEPTH, N_EXPERTS, D_EXPERT, D_MODEL), D_EXPERT ** -0.5 * DEEPNORM_BETA),
        "ln2_g": 1.0 + nrm(ks[15], (DEPTH, D_MODEL), 0.02),
        "ln2_b": nrm(ks[16], (DEPTH, D_MODEL), 0.02),
    }


def reference(x, c, w_mod, b_mod, w_in, b_forget, out_norm_g, w_out, ln1_g, ln1_b,
              w_router, b_router, w_gate, w_up, w_down, ln2_g, ln2_b):
    B, S, D = x.shape
    cond = jax.nn.silu(c)
    for l in range(DEPTH):
        mod = (cond @ w_mod[l] + b_mod[l])[:, None, :]
        sh_a, sc_a, g_a, sh_f, sc_f, g_f = jnp.split(mod, N_MOD, axis=-1)
        u = x * (1.0 + sc_a) + sh_a
        y = hybrid_mixer(u, w_in[l], b_forget[l], out_norm_g[l], w_out[l])
        x = layer_norm(DEEPNORM_ALPHA * x + (1.0 + g_a) * y, ln1_g[l], ln1_b[l])
        u = x * (1.0 + sc_f) + sh_f
        y = grouped_moe(u.reshape(B * S, D), w_router, b_router, w_gate[l], w_up[l], w_down[l]).reshape(B, S, D)
        x = layer_norm(DEEPNORM_ALPHA * x + (1.0 + g_f) * y, ln2_g[l], ln2_b[l])
    return x
```

```cpp
#include <hip/hip_runtime.h>
#include <cstdio>
#include <cstdint>
#include <cmath>
namespace ref {
constexpr int B = 2, S = 8192, D = 1024, M = B * S, DEPTH = 4, HD = 64, NH = 16, NFOX = 8, NSB = 8, DFOX = 512;
constexpr int NIN = 3592, NMODC = 6144, NE = 16;
constexpr int C_FQ = 0, C_FK = 512, C_FV = 1024, C_FG = 1536, C_FF = 2048, C_SQ = 2056, C_SK = 2568, C_SV = 3080;
constexpr float ALPHA = 1.6817928305074292f;
constexpr float LN_EPS = 1e-5f, RMS_EPS = 1e-6f;
constexpr int MO_SHA = 0, MO_SCA = 1024, MO_GA = 2048, MO_SHF = 3072, MO_SCF = 4096, MO_GF = 5120;

__device__ __forceinline__ float log_sigmoid(float z) { return fminf(z, 0.f) - log1pf(expf(-fabsf(z))); }
__device__ __forceinline__ float wsum(float v) {
#pragma unroll
    for (int o = 1; o < 64; o <<= 1) v += __shfl_xor(v, o);
    return v;
}

__global__ void __launch_bounds__(256) k_mod(const float* __restrict__ c, const float* __restrict__ w_mod, const float* __restrict__ b_mod, float* __restrict__ mod) {
    const int idx = blockIdx.x * 256 + threadIdx.x;
    const int l = idx / NMODC, n = idx % NMODC;
    const float* w = w_mod + (size_t)l * D * NMODC + n;
    float a0 = 0.f, a1 = 0.f;
    for (int k = 0; k < D; ++k) {
        const float wv = w[(size_t)k * NMODC];
        float c0 = c[k], c1 = c[D + k];
        c0 = c0 / (1.f + expf(-c0)); c1 = c1 / (1.f + expf(-c1));
        a0 += c0 * wv; a1 += c1 * wv;
    }
    const float bb = b_mod[l * NMODC + n];
    mod[(size_t)(l * 2 + 0) * NMODC + n] = a0 + bb;
    mod[(size_t)(l * 2 + 1) * NMODC + n] = a1 + bb;
}

__global__ void __launch_bounds__(256) k_modulate(const float* __restrict__ X, const float* __restrict__ modl, int off_sh, int off_sc, float* __restrict__ U) {
    const size_t i = (size_t)blockIdx.x * 256 + threadIdx.x;
    const int m = (int)(i / D), k = (int)(i % D), b = m / S;
    const float* mo = modl + (size_t)b * NMODC;
    U[i] = X[i] * (1.f + mo[off_sc + k]) + mo[off_sh + k];
}

__global__ void __launch_bounds__(256) k_gemm(const float* __restrict__ A, int lda, const float* __restrict__ Bm, int ldb, float* __restrict__ C, int ldc, int N, int K) {
    __shared__ float As[16][68];
    __shared__ float Bs[16][68];
    const int tx = threadIdx.x & 15, ty = threadIdx.x >> 4;
    const int row0 = blockIdx.y * 64, col0 = blockIdx.x * 64;
    float acc[4][4];
#pragma unroll
    for (int i = 0; i < 4; ++i)
#pragma unroll
        for (int j = 0; j < 4; ++j) acc[i][j] = 0.f;
    for (int k0 = 0; k0 < K; k0 += 16) {
        {
            const int r = threadIdx.x >> 2, kk = (threadIdx.x & 3) * 4;
            const float* ap = A + (size_t)(row0 + r) * lda + k0 + kk;
#pragma unroll
            for (int j = 0; j < 4; ++j) As[kk + j][r] = ap[j];
        }
        {
            const int kk = threadIdx.x >> 4, cc = (threadIdx.x & 15) * 4;
#pragma unroll
            for (int j = 0; j < 4; ++j) { const int col = col0 + cc + j; Bs[kk][cc + j] = (col < N) ? Bm[(size_t)(k0 + kk) * ldb + col] : 0.f; }
        }
        __syncthreads();
#pragma unroll
        for (int kk = 0; kk < 16; ++kk) {
            float a[4], b[4];
#pragma unroll
            for (int i = 0; i < 4; ++i) a[i] = As[kk][ty * 4 + i];
#pragma unroll
            for (int j = 0; j < 4; ++j) b[j] = Bs[kk][tx * 4 + j];
#pragma unroll
            for (int i = 0; i < 4; ++i)
#pragma unroll
                for (int j = 0; j < 4; ++j) acc[i][j] += a[i] * b[j];
        }
        __syncthreads();
    }
#pragma unroll
    for (int i = 0; i < 4; ++i)
#pragma unroll
        for (int j = 0; j < 4; ++j) { const int col = col0 + tx * 4 + j; if (col < N) C[(size_t)(row0 + ty * 4 + i) * ldc + col] = acc[i][j]; }
}

template <int MODE>
__global__ void __launch_bounds__(256) k_gemm_grouped(const float* __restrict__ A, const int* __restrict__ list, const int* __restrict__ cnt, const int* __restrict__ offs,
                                                      const float* __restrict__ W0, const float* __restrict__ W1, float* __restrict__ C) {
    __shared__ float As[16][68];
    __shared__ float Bs[16][68];
    __shared__ float Bs2[16][68];
    const int e = blockIdx.z, n_e = cnt[e], off_e = offs[e];
    const int row0 = blockIdx.y * 64;
    if (row0 >= n_e) return;
    const int tx = threadIdx.x & 15, ty = threadIdx.x >> 4, col0 = blockIdx.x * 64;
    const float* Wa = W0 + (size_t)e * D * D; const float* Wb = (MODE == 0) ? W1 + (size_t)e * D * D : nullptr;
    float acc[4][4], acc2[4][4];
#pragma unroll
    for (int i = 0; i < 4; ++i)
#pragma unroll
        for (int j = 0; j < 4; ++j) { acc[i][j] = 0.f; acc2[i][j] = 0.f; }
    const int r = threadIdx.x >> 2, kq = (threadIdx.x & 3) * 4;
    int rr = row0 + r; if (rr >= n_e) rr = n_e - 1;
    const float* arow = (MODE == 0) ? A + (size_t)list[(size_t)e * M + rr] * D : A + (size_t)(off_e + rr) * D;
    for (int k0 = 0; k0 < D; k0 += 16) {
#pragma unroll
        for (int j = 0; j < 4; ++j) As[kq + j][r] = arow[k0 + kq + j];
        {
            const int kk = threadIdx.x >> 4, cc = (threadIdx.x & 15) * 4;
#pragma unroll
            for (int j = 0; j < 4; ++j) { Bs[kk][cc + j] = Wa[(size_t)(k0 + kk) * D + col0 + cc + j]; if (MODE == 0) Bs2[kk][cc + j] = Wb[(size_t)(k0 + kk) * D + col0 + cc + j]; }
        }
        __syncthreads();
#pragma unroll
        for (int kk = 0; kk < 16; ++kk) {
            float a[4], b[4], b2[4];
#pragma unroll
            for (int i = 0; i < 4; ++i) a[i] = As[kk][ty * 4 + i];
#pragma unroll
            for (int j = 0; j < 4; ++j) { b[j] = Bs[kk][tx * 4 + j]; if (MODE == 0) b2[j] = Bs2[kk][tx * 4 + j]; }
#pragma unroll
            for (int i = 0; i < 4; ++i)
#pragma unroll
                for (int j = 0; j < 4; ++j) { acc[i][j] += a[i] * b[j]; if (MODE == 0) acc2[i][j] += a[i] * b2[j]; }
        }
        __syncthreads();
    }
#pragma unroll
    for (int i = 0; i < 4; ++i) {
        const int ro = row0 + ty * 4 + i; if (ro >= n_e) continue;
#pragma unroll
        for (int j = 0; j < 4; ++j) {
            float v = acc[i][j];
            if (MODE == 0) { v = v / (1.f + expf(-v)) * acc2[i][j]; }
            C[(size_t)(off_e + ro) * D + col0 + tx * 4 + j] = v;
        }
    }
}

__global__ void __launch_bounds__(256) k_forget_scan(const float* __restrict__ P, int ldp, int colf, const float* __restrict__ bf, float* __restrict__ F) {
    __shared__ float part[256];
    const int bh = blockIdx.x, b = bh / NFOX, h = bh % NFOX, t0 = threadIdx.x * 32;
    float v[32]; float s = 0.f;
#pragma unroll
    for (int i = 0; i < 32; ++i) { v[i] = log_sigmoid(P[(size_t)(b * S + t0 + i) * ldp + colf + h] + bf[h]); s += v[i]; }
    part[threadIdx.x] = s; __syncthreads();
    if (threadIdx.x == 0) { float run = 0.f; for (int i = 0; i < 256; ++i) { const float x = part[i]; part[i] = run; run += x; } }
    __syncthreads();
    float run = part[threadIdx.x];
#pragma unroll
    for (int i = 0; i < 32; ++i) { run += v[i]; F[(size_t)bh * S + t0 + i] = run; }
}

__global__ void __launch_bounds__(256) k_fox(const float* __restrict__ P, int ldp, int cq, int ck, int cv, const float* __restrict__ F, float* __restrict__ O) {
    const int t = blockIdx.x * 256 + threadIdx.x, h = blockIdx.y, b = blockIdx.z;
    const float* qp = P + (size_t)(b * S + t) * ldp + cq + h * HD;
    float q[64], acc[64];
#pragma unroll
    for (int i = 0; i < 64; ++i) { q[i] = qp[i] * 0.125f; acc[i] = 0.f; }
    const float* Fh = F + (size_t)(b * NFOX + h) * S;
    const float Ft = Fh[t];
    float mx = -INFINITY, l = 0.f;
    const int send = t | 63;
    for (int s = 0; s <= send; ++s) {
        const float* kp = P + (size_t)(b * S + s) * ldp + ck + h * HD;
        const float* vp = P + (size_t)(b * S + s) * ldp + cv + h * HD;
        float d = 0.f;
#pragma unroll
        for (int i = 0; i < 64; ++i) d += q[i] * kp[i];
        const float lg = d + Ft - Fh[s];
        if (s <= t) {
            const float mn = fmaxf(mx, lg), sc = expf(mx - mn), p = expf(lg - mn);
            l = l * sc + p;
#pragma unroll
            for (int i = 0; i < 64; ++i) acc[i] = acc[i] * sc + p * vp[i];
            mx = mn;
        }
    }
    float* op = O + (size_t)(b * S + t) * D + h * HD;
    const float inv = 1.f / l;
#pragma unroll
    for (int i = 0; i < 64; ++i) op[i] = acc[i] * inv;
}

__global__ void __launch_bounds__(256) k_sb(const float* __restrict__ P, int ldp, int cq, int ck, int cv, float* __restrict__ O) {
    const int t = blockIdx.x * 256 + threadIdx.x, h = blockIdx.y, b = blockIdx.z;
    const float* qp = P + (size_t)(b * S + t) * ldp + cq + h * HD;
    float q[64], acc[64];
#pragma unroll
    for (int i = 0; i < 64; ++i) { q[i] = qp[i] * 0.125f; acc[i] = 0.f; }
    float later = 0.f;
    const int sstart = (t | 63);
    for (int s = sstart; s >= 0; --s) {
        const float* kp = P + (size_t)(b * S + s) * ldp + ck + h * HD;
        const float* vp = P + (size_t)(b * S + s) * ldp + cv + h * HD;
        float z = 0.f;
#pragma unroll
        for (int i = 0; i < 64; ++i) z += q[i] * kp[i];
        if (s < t) {
            const float lb = log_sigmoid(z);
            const float w = expf(lb + later);
#pragma unroll
            for (int i = 0; i < 64; ++i) acc[i] += w * vp[i];
            later += lb - z;
        }
    }
    float* op = O + (size_t)(b * S + t) * D + DFOX + h * HD;
#pragma unroll
    for (int i = 0; i < 64; ++i) op[i] = acc[i];
}

__global__ void __launch_bounds__(256) k_rms_gate(float* __restrict__ O, const float* __restrict__ P, int ldp, int cg, const float* __restrict__ g) {
    const int i = blockIdx.x * 256 + threadIdx.x; const int m = i / NH, h = i % NH;
    float* op = O + (size_t)m * D + h * HD;
    float ss = 0.f;
    for (int d = 0; d < HD; ++d) ss += op[d] * op[d];
    const float r = 1.f / sqrtf(ss * (1.f / HD) + RMS_EPS);
    for (int d = 0; d < HD; ++d) {
        float v = op[d] * r * g[h * HD + d];
        if (h < NFOX) { const float gt = P[(size_t)m * ldp + cg + h * HD + d]; v *= 1.f / (1.f + expf(-gt)); }
        op[d] = v;
    }
}

__global__ void __launch_bounds__(256) k_ln(const float* __restrict__ X, const float* __restrict__ Y, const float* __restrict__ modl, int off_g, const float* __restrict__ lg, const float* __restrict__ lb,
                                            float* __restrict__ Xout) {
    const int m = blockIdx.x * 4 + (threadIdx.x >> 6), lane = threadIdx.x & 63, b = m / S;
    const float* mo = modl + (size_t)b * NMODC + off_g;
    float v[16]; float s = 0.f;
#pragma unroll
    for (int j = 0; j < 16; ++j) { const int k = j * 64 + lane; v[j] = ALPHA * X[(size_t)m * D + k] + (1.f + mo[k]) * Y[(size_t)m * D + k]; s += v[j]; }
    const float mu = wsum(s) * (1.f / D); float q = 0.f;
#pragma unroll
    for (int j = 0; j < 16; ++j) { v[j] -= mu; q += v[j] * v[j]; }
    const float rstd = 1.f / sqrtf(wsum(q) * (1.f / D) + LN_EPS);
#pragma unroll
    for (int j = 0; j < 16; ++j) { const int k = j * 64 + lane; Xout[(size_t)m * D + k] = v[j] * rstd * lg[k] + lb[k]; }
}

__global__ void __launch_bounds__(256) k_router(const float* __restrict__ U2, const float* __restrict__ wr, const float* __restrict__ br, int* __restrict__ cnt, int* __restrict__ list,
                                                int* __restrict__ tok_e, int* __restrict__ tok_pos, float* __restrict__ tok_w) {
    const int m = blockIdx.x * 4 + (threadIdx.x >> 6), lane = threadIdx.x & 63;
    float lg[NE];
#pragma unroll
    for (int e = 0; e < NE; ++e) lg[e] = 0.f;
    for (int j = 0; j < 16; ++j) { const int k = j * 64 + lane; const float u = U2[(size_t)m * D + k];
#pragma unroll
        for (int e = 0; e < NE; ++e) lg[e] += u * wr[k * NE + e]; }
#pragma unroll
    for (int e = 0; e < NE; ++e) lg[e] = wsum(lg[e]);
    if (lane == 0) {
        float mx = lg[0];
#pragma unroll
        for (int e = 1; e < NE; ++e) mx = fmaxf(mx, lg[e]);
        float pr[NE], sel[NE]; float sum = 0.f;
#pragma unroll
        for (int e = 0; e < NE; ++e) { pr[e] = expf(lg[e] - mx); sum += pr[e]; }
#pragma unroll
        for (int e = 0; e < NE; ++e) { pr[e] /= sum; sel[e] = pr[e] + br[e]; }
        int bg = 0; float bgs = -INFINITY;
#pragma unroll
        for (int g = 0; g < 4; ++g) {
            float a = -INFINITY, b2 = -INFINITY;
#pragma unroll
            for (int i = 0; i < 4; ++i) { const float x = sel[g * 4 + i]; if (x > a) { b2 = a; a = x; } else if (x > b2) b2 = x; }
            const float gs = a + b2; if (gs > bgs) { bgs = gs; bg = g; }
        }
        int i0 = -1, i1 = -1; float a = -INFINITY, b2 = -INFINITY;
#pragma unroll
        for (int g = 0; g < 4; ++g) if (g == bg) {
#pragma unroll
            for (int i = 0; i < 4; ++i) { const float x = sel[g * 4 + i]; if (x > a) { b2 = a; i1 = i0; a = x; i0 = g * 4 + i; } else if (x > b2) { b2 = x; i1 = g * 4 + i; } }
        }
        float p0 = 0.f, p1 = 0.f;
#pragma unroll
        for (int e = 0; e < NE; ++e) { if (e == i0) p0 = pr[e]; if (e == i1) p1 = pr[e]; }
        const float ws = p0 + p1;
        const int pos0 = atomicAdd(&cnt[i0], 1), pos1 = atomicAdd(&cnt[i1], 1);
        list[(size_t)i0 * M + pos0] = m; list[(size_t)i1 * M + pos1] = m;
        tok_e[m * 2] = i0; tok_e[m * 2 + 1] = i1; tok_pos[m * 2] = pos0; tok_pos[m * 2 + 1] = pos1; tok_w[m * 2] = p0 / ws; tok_w[m * 2 + 1] = p1 / ws;
    }
}
__global__ void k_offs(const int* __restrict__ cnt, int* __restrict__ offs) { if (threadIdx.x == 0) { int run = 0; for (int e = 0; e < NE; ++e) { offs[e] = run; run += cnt[e]; } } }

__global__ void __launch_bounds__(256) k_combine(const float* __restrict__ Yd, const int* __restrict__ offs, const int* __restrict__ tok_e, const int* __restrict__ tok_pos, const float* __restrict__ tok_w, float* __restrict__ Y) {
    const size_t i = (size_t)blockIdx.x * 256 + threadIdx.x; const int m = (int)(i / D), k = (int)(i % D);
    const int r0 = offs[tok_e[m * 2]] + tok_pos[m * 2], r1 = offs[tok_e[m * 2 + 1]] + tok_pos[m * 2 + 1];
    Y[i] = tok_w[m * 2] * Yd[(size_t)r0 * D + k] + tok_w[m * 2 + 1] * Yd[(size_t)r1 * D + k];
}
}
namespace ref {
constexpr size_t MiBr = 1u << 20;
struct RefWs {
    static constexpr size_t MOD = 0, CNT = 256 * 1024, OFFS = CNT + 1024, LIST = 1 * MiBr, TOKE = 2 * MiBr, TOKP = TOKE + 256 * 1024, TOKW = TOKP + 256 * 1024,
                            F = 3 * MiBr, U = 4 * MiBr, P = U + 64 * MiBr, O = P + 236 * MiBr, Y = O + 64 * MiBr, X1 = Y + 64 * MiBr, HH = X1 + 64 * MiBr, END = HH + 128 * MiBr;
};
struct Inputs { const float *x, *c, *w_mod, *b_mod, *w_in, *b_forget, *out_norm_g, *w_out, *ln1_g, *ln1_b, *w_router, *b_router, *w_gate, *w_up, *w_down, *ln2_g, *ln2_b; };

static void layer_mixer(const Inputs& in, int l, const float* Xin, unsigned char* w, hipStream_t st) {
    float* mod = (float*)(w + RefWs::MOD) + (size_t)l * 2 * NMODC;
    float *U = (float*)(w + RefWs::U), *P = (float*)(w + RefWs::P), *O = (float*)(w + RefWs::O), *Y = (float*)(w + RefWs::Y), *Fb = (float*)(w + RefWs::F);
    k_modulate<<<M * D / 256, 256, 0, st>>>(Xin, mod, MO_SHA, MO_SCA, U);
    k_gemm<<<dim3((NIN + 63) / 64, M / 64), 256, 0, st>>>(U, D, in.w_in + (size_t)l * D * NIN, NIN, P, NIN, NIN, D);
    k_forget_scan<<<B * NFOX, 256, 0, st>>>(P, NIN, C_FF, in.b_forget + l * NFOX, Fb);
    k_fox<<<dim3(S / 256, NFOX, B), 256, 0, st>>>(P, NIN, C_FQ, C_FK, C_FV, Fb, O);
    k_sb<<<dim3(S / 256, NSB, B), 256, 0, st>>>(P, NIN, C_SQ, C_SK, C_SV, O);
    k_rms_gate<<<M * NH / 256, 256, 0, st>>>(O, P, NIN, C_FG, in.out_norm_g + (size_t)l * D);
    k_gemm<<<dim3(D / 64, M / 64), 256, 0, st>>>(O, D, in.w_out + (size_t)l * D * D, D, Y, D, D, D);
}
static void layer_moe(const Inputs& in, int l, const float* X1, unsigned char* w, hipStream_t st) {
    float* mod = (float*)(w + RefWs::MOD) + (size_t)l * 2 * NMODC;
    float *U = (float*)(w + RefWs::U), *Y = (float*)(w + RefWs::Y), *HH = (float*)(w + RefWs::HH), *YD = (float*)(w + RefWs::P);
    int *cnt = (int*)(w + RefWs::CNT), *offs = (int*)(w + RefWs::OFFS), *list = (int*)(w + RefWs::LIST), *toke = (int*)(w + RefWs::TOKE), *tokp = (int*)(w + RefWs::TOKP); float* tokw = (float*)(w + RefWs::TOKW);
    k_modulate<<<M * D / 256, 256, 0, st>>>(X1, mod, MO_SHF, MO_SCF, U);
    hipMemsetAsync(cnt, 0, 64, st);
    k_router<<<M / 4, 256, 0, st>>>(U, in.w_router, in.b_router, cnt, list, toke, tokp, tokw);
    k_offs<<<1, 64, 0, st>>>(cnt, offs);
    const size_t eo = (size_t)l * NE * D * D;
    k_gemm_grouped<0><<<dim3(D / 64, M / 64, NE), 256, 0, st>>>(U, list, cnt, offs, in.w_gate + eo, in.w_up + eo, HH);
    k_gemm_grouped<1><<<dim3(D / 64, M / 64, NE), 256, 0, st>>>(HH, list, cnt, offs, in.w_down + eo, nullptr, YD);
    k_combine<<<M * D / 256, 256, 0, st>>>(YD, offs, toke, tokp, tokw, Y);
}
static void forward(const Inputs& in, float* out, unsigned char* w, hipStream_t st) {
    float* mod = (float*)(w + RefWs::MOD);
    float *Y = (float*)(w + RefWs::Y), *X1 = (float*)(w + RefWs::X1);
    k_mod<<<DEPTH * NMODC / 256, 256, 0, st>>>(in.c, in.w_mod, in.b_mod, mod);
    for (int l = 0; l < DEPTH; ++l) {
        const float* Xin = (l == 0) ? in.x : out;
        float* modl = mod + (size_t)l * 2 * NMODC;
        layer_mixer(in, l, Xin, w, st);
        k_ln<<<M / 4, 256, 0, st>>>(Xin, Y, modl, MO_GA, in.ln1_g + (size_t)l * D, in.ln1_b + (size_t)l * D, X1);
        layer_moe(in, l, X1, w, st);
        k_ln<<<M / 4, 256, 0, st>>>(X1, Y, modl, MO_GF, in.ln2_g + (size_t)l * D, in.ln2_b + (size_t)l * D, out);
    }
}
}
extern "C" void kernel_launch(void* const* d_in, const int* in_sizes, int n_in, void* d_out, int out_size, void* d_ws, size_t ws_size, hipStream_t stream) {
    ref::Inputs in;
    const float** f = (const float**)&in;
    for (int i = 0; i < 17; ++i) f[i] = (const float*)d_in[i];
    if (ws_size < ref::RefWs::END) { fprintf(stderr, "ws too small: %zu < %zu\n", ws_size, (size_t)ref::RefWs::END); return; }
    ref::forward(in, (float*)d_out, (unsigned char*)d_ws, stream);
}
```

```cpp
#include <hip/hip_runtime.h>
#include <cstdio>
#include <cstdint>
#include <cmath>
namespace pg8 {
#define PG8_LAS __attribute__((address_space(3)))
typedef unsigned short bf16_t;
typedef short bf16x8 __attribute__((ext_vector_type(8)));
typedef float f32x4 __attribute__((ext_vector_type(4)));
typedef unsigned u32x4 __attribute__((ext_vector_type(4)));
constexpr int BM = 256, BK = 64, HALF = 128, HTB = HALF * BK * 2  , STAGE_BYTES = 8 * HTB, NXCD = 8, WGM = 8;

__host__ __device__ __forceinline__ int lds_byte(int r, int c) { const int st = (r >> 4) * 2 + (c >> 5), rr = r & 15, cc = c & 31, ob = rr * 64 + cc * 2; return st * 1024 + (ob ^ (((ob >> 9) & 1) << 5)); }
__host__ __device__ __forceinline__ void stage_rc(int b, int& R, int& C) { const int st = b / 1024, sb = b % 1024, swz = sb ^ (((sb >> 9) & 1) << 5); R = (st >> 1) * 16 + swz / 64; C = (st & 1) * 32 + (swz % 64) / 2; }
__host__ __device__ __forceinline__ int perm32(int rho) { const int n = rho >> 4, i = rho & 15; return 8 * (i >> 2) + 4 * n + (i & 3); }

struct Unit { int pm, pn, e, r0, nv; };

struct DenseSched {
    const bf16_t* A; const bf16_t* Bt; int K; int nM, nN, nwg, G, c;
    __device__ void init(const bf16_t* A_, const bf16_t* Bt_, int M, int N, int K_, int G_, int c_) { A = A_; Bt = Bt_; K = K_; nM = M / BM; nN = N / BM; nwg = nM * nN; G = G_; c = c_; }
    __device__ __forceinline__ bool next(int i, Unit& u) const {
        const long L = (long)i * G + c; if (L >= nwg) return false;
        int wgid = (int)L; { const int q = nwg / NXCD, r = nwg % NXCD, xcd = wgid % NXCD, off = wgid / NXCD; wgid = (xcd < r ? xcd * (q + 1) : r * (q + 1) + (xcd - r) * q) + off; }
        const int nig = WGM * nN, gid = wgid / nig, fm = gid * WGM, gsz = (nM - fm) < WGM ? (nM - fm) : WGM;
        u.pm = fm + ((wgid % nig) % gsz); u.pn = (wgid % nig) / gsz; u.e = 0; u.r0 = 0; u.nv = 256; return true;
    }
    __device__ __forceinline__ const char* aptr(const Unit& u) const { return (const char*)A + (size_t)u.pm * (size_t)(2 * HALF) * K * 2; }
    __device__ __forceinline__ const char* bptr(const Unit& u) const { return (const char*)Bt + (size_t)u.pn * (size_t)(2 * HALF) * K * 2; }
};

__device__ __forceinline__ unsigned cvt_pk_bf16(float lo, float hi) { unsigned r; asm volatile("v_cvt_pk_bf16_f32 %0, %1, %2" : "=v"(r) : "v"(lo), "v"(hi)); return r; }

struct EpiBf16S {
    static constexpr bool PERM = true;
    bf16_t* O; int ldc; unsigned qmask; float sc_q;
    __device__ __forceinline__ void operator()(const f32x4 (&acc)[2][2][4][2], const Unit& u, int wr, int wc, int fr, int fq) const {
        const int row0 = u.pm * BM + wr * 64 + fr, col0 = u.pn * BM + wc * 32 + 8 * fq;
        const float sc = ((qmask >> u.pn) & 1u) ? sc_q : 1.f;
#pragma unroll
        for (int ai = 0; ai < 2; ++ai)
#pragma unroll
            for (int m = 0; m < 4; ++m) { bf16_t* rowp = O + (size_t)(row0 + ai * HALF + m * 16) * ldc + col0;
#pragma unroll
                for (int bj = 0; bj < 2; ++bj) { const f32x4 v0 = acc[ai][bj][m][0] * sc, v1 = acc[ai][bj][m][1] * sc;
                    u32x4 w; w.x = cvt_pk_bf16(v0[0], v0[1]); w.y = cvt_pk_bf16(v0[2], v0[3]); w.z = cvt_pk_bf16(v1[0], v1[1]); w.w = cvt_pk_bf16(v1[2], v1[3]);
                    *(u32x4*)(rowp + bj * HALF) = w; } }
    }
};
struct EpiF32 {
    static constexpr bool PERM = false;
    float* O; int ldc;
    __device__ __forceinline__ void operator()(const f32x4 (&acc)[2][2][4][2], const Unit& u, int wr, int wc, int fr, int fq) const {
        const int row0 = u.pm * BM + wr * 64 + fr, col0 = u.pn * BM + wc * 32 + 4 * fq;
#pragma unroll
        for (int ai = 0; ai < 2; ++ai)
#pragma unroll
            for (int m = 0; m < 4; ++m) { float* rowp = O + (size_t)(row0 + ai * HALF + m * 16) * ldc + col0;
#pragma unroll
                for (int bj = 0; bj < 2; ++bj)
#pragma unroll
                    for (int n = 0; n < 2; ++n) *(f32x4*)(rowp + bj * HALF + n * 16) = acc[ai][bj][m][n]; }
    }
};
struct EpiGateUp {
    static constexpr bool PERM = true;
    bf16_t* O; int ldc;
    __device__ __forceinline__ void operator()(const f32x4 (&acc)[2][2][4][2], const Unit& u, int wr, int wc, int fr, int fq) const {
        const int row0 = u.pm * BM + wr * 64 + fr, col0 = u.pn * HALF + wc * 32 + 8 * fq;
#pragma unroll
        for (int ai = 0; ai < 2; ++ai)
#pragma unroll
            for (int m = 0; m < 4; ++m) { bf16_t* rowp = O + (size_t)(row0 + ai * HALF + m * 16) * ldc + col0;
                float h[8];
#pragma unroll
                for (int n = 0; n < 2; ++n)
#pragma unroll
                    for (int j = 0; j < 4; ++j) { const float g = acc[ai][0][m][n][j], up = acc[ai][1][m][n][j];
                        const float sg = __builtin_amdgcn_rcpf(1.f + __builtin_amdgcn_exp2f(-1.4426950408889634f * g)); h[n * 4 + j] = g * sg * up; }
                u32x4 w; w.x = cvt_pk_bf16(h[0], h[1]); w.y = cvt_pk_bf16(h[2], h[3]); w.z = cvt_pk_bf16(h[4], h[5]); w.w = cvt_pk_bf16(h[6], h[7]);
                *(u32x4*)rowp = w; }
    }
};

template <class Epi, class Sched, bool ALIGN_EPI, bool GATHER>
__device__ __forceinline__ void gemm_phase(PG8_LAS unsigned char* lds, const int K, const Sched& S, const Epi& E) {
    int tid_ = threadIdx.x; asm volatile("" : "+v"(tid_));
    const int tid = tid_, wid = __builtin_amdgcn_readfirstlane(tid >> 6), lane = tid & 63, wr = wid >> 2, wc = wid & 3, fr = lane & 15, fq = lane >> 4;
    const int nt = K / BK;
    unsigned voffB[2]; int RA0; unsigned CA2;
    { int R, C; stage_rc(tid * 16, R, C); RA0 = R; CA2 = (unsigned)C * 2u;
#pragma unroll
      for (int i = 0; i < 2; ++i) { const int Ri = R + 64 * i, Rb = Epi::PERM ? ((Ri & ~31) + perm32(Ri & 31)) : Ri; voffB[i] = (unsigned)(Rb * K + C) * 2u; } }
    const size_t kstep = (size_t)(BK * 2);
    const size_t hstep = (size_t)HALF * K * 2;
    const unsigned ldsw = (unsigned)wid * 1024u;
    const int aoff = lds_byte(wr * 64 + fr, fq * 8), boff = lds_byte(wc * 32 + fr, fq * 8);
#define PG8_SA(b, h) (((b) * 2 + (h)) * HTB)
#define PG8_SB(b, h) ((4 + (b) * 2 + (h)) * HTB)
#define PG8_STAGE(bufoff, gbase, voff) do { _Pragma("unroll") for (int _i = 0; _i < 2; ++_i) \
        __builtin_amdgcn_global_load_lds((const unsigned*)((const char*)(gbase) + (voff)[_i]), (PG8_LAS unsigned*)(lds + (bufoff) + ldsw + _i * 8192), 16, 0, 0); } while (0)
#define PG8_LDA(dst, b, h) do { _Pragma("unroll") for (int m = 0; m < 4; ++m) _Pragma("unroll") for (int k = 0; k < 2; ++k) dst[m][k] = *(const PG8_LAS bf16x8*)(lds + PG8_SA(b, h) + aoff + m * 2048 + k * 1024); } while (0)
#define PG8_LDB(dst, b, h) do { _Pragma("unroll") for (int n = 0; n < 2; ++n) _Pragma("unroll") for (int k = 0; k < 2; ++k) dst[n][k] = *(const PG8_LAS bf16x8*)(lds + PG8_SB(b, h) + boff + n * 2048 + k * 1024); } while (0)
#define PG8_MMA(ai, bj, At, Bt) do { __builtin_amdgcn_s_setprio(1); _Pragma("unroll") for (int m = 0; m < 4; ++m) _Pragma("unroll") for (int n = 0; n < 2; ++n) _Pragma("unroll") for (int k = 0; k < 2; ++k) \
        acc[ai][bj][m][n] = __builtin_amdgcn_mfma_f32_16x16x32_bf16(Bt[n][k], At[m][k], acc[ai][bj][m][n], 0, 0, 0); __builtin_amdgcn_s_setprio(0); } while (0)
#define PG8_WAIT_V(n) asm volatile("s_waitcnt vmcnt(" #n ")" ::: "memory")
#define PG8_WAIT_L(n) asm volatile("s_waitcnt lgkmcnt(" #n ")" ::: "memory")
#define PG8_BAR __builtin_amdgcn_s_barrier()
#define PG8_SCHED __builtin_amdgcn_sched_barrier(0)
    Unit cur, nxt; int ui = 0;
    if (!S.next(0, cur)) return;
    f32x4 acc[2][2][4][2];
    float zf = 0.f; asm volatile("" : "+v"(zf));
#pragma unroll
    for (int a = 0; a < 2; ++a)
#pragma unroll
        for (int b = 0; b < 2; ++b)
#pragma unroll
            for (int m = 0; m < 4; ++m)
#pragma unroll
                for (int n = 0; n < 2; ++n) acc[a][b][m][n] = (f32x4){zf, zf, zf, zf};
    bf16x8 At[4][2], B0[2][2], B1[2][2];
    unsigned oc[2][2], on[2][2];
#define PG8_AOFF(dst, u) do { if constexpr (GATHER) { int _t[4]; S.arows4(u, RA0, _t); \
            _Pragma("unroll") for (int _k = 0; _k < 4; ++_k) dst[_k >> 1][_k & 1] = (unsigned)_t[_k] * (unsigned)(K * 2) + CA2; } \
        else { _Pragma("unroll") for (int _k = 0; _k < 4; ++_k) dst[_k >> 1][_k & 1] = (unsigned)((RA0 + 64 * _k) * K) * 2u + CA2; } } while (0)
    PG8_AOFF(oc, cur);
    const char* cA = S.aptr(cur); const char* cB = S.bptr(cur);
    PG8_STAGE(PG8_SB(0, 0), cB, voffB); PG8_STAGE(PG8_SB(0, 1), cB + hstep, voffB); PG8_STAGE(PG8_SA(0, 0), cA, oc[0]); PG8_STAGE(PG8_SA(0, 1), cA, oc[1]);
    if (wr == 1) PG8_BAR;
    PG8_WAIT_V(2); PG8_BAR;
    PG8_STAGE(PG8_SB(1, 0), cB + kstep, voffB); PG8_STAGE(PG8_SA(1, 0), cA + kstep, oc[0]); PG8_STAGE(PG8_SB(1, 1), cB + hstep + kstep, voffB);
    PG8_WAIT_V(6); PG8_BAR;
    for (;;) {
        const bool has_next = S.next(ui + 1, nxt);
        const char* nA = has_next ? S.aptr(nxt) : cA; const char* nB = has_next ? S.bptr(nxt) : cB;
        if (has_next) { PG8_AOFF(on, nxt); } else {
#pragma unroll
            for (int _h = 0; _h < 2; ++_h)
#pragma unroll
                for (int _i = 0; _i < 2; ++_i) on[_h][_i] = oc[_h][_i]; }
        for (int t = 0; t < nt; t += 2) {
            const bool last = (t == nt - 2);
            const char* a1 = cA + (size_t)(t + 1) * kstep;
            const char* a2 = last ? nA : cA + (size_t)(t + 2) * kstep; const char* b2 = last ? nB : cB + (size_t)(t + 2) * kstep;
            const char* a3 = a2 + kstep; const char* b3 = b2 + kstep;
            unsigned o2[2][2];
#pragma unroll
            for (int _h = 0; _h < 2; ++_h)
#pragma unroll
                for (int _i = 0; _i < 2; ++_i) o2[_h][_i] = last ? on[_h][_i] : oc[_h][_i];
            PG8_LDB(B0, 0, 0); PG8_LDB(B1, 0, 1); PG8_SCHED; PG8_LDA(At, 0, 0); PG8_STAGE(PG8_SA(1, 1), a1, oc[1]);
            PG8_WAIT_V(8); PG8_WAIT_L(0); PG8_BAR; PG8_MMA(0, 0, At, B0); PG8_MMA(0, 1, At, B1); PG8_BAR; PG8_SCHED;
            PG8_LDA(At, 0, 1); PG8_STAGE(PG8_SB(0, 0), b2, voffB); PG8_STAGE(PG8_SB(0, 1), b2 + hstep, voffB); PG8_STAGE(PG8_SA(0, 0), a2, o2[0]);
            PG8_WAIT_V(8); PG8_WAIT_L(0); PG8_BAR; PG8_MMA(1, 0, At, B0); PG8_MMA(1, 1, At, B1); PG8_BAR; PG8_SCHED;
            PG8_LDB(B0, 1, 0); PG8_LDB(B1, 1, 1); PG8_SCHED; PG8_LDA(At, 1, 0); PG8_STAGE(PG8_SA(0, 1), a2, o2[1]);
            PG8_WAIT_V(8); PG8_WAIT_L(0); PG8_BAR; PG8_MMA(0, 0, At, B0); PG8_MMA(0, 1, At, B1); PG8_BAR; PG8_SCHED;
            PG8_LDA(At, 1, 1); PG8_STAGE(PG8_SB(1, 0), b3, voffB); PG8_STAGE(PG8_SB(1, 1), b3 + hstep, voffB); PG8_STAGE(PG8_SA(1, 0), a3, o2[0]);
            PG8_WAIT_V(8); PG8_WAIT_L(0); PG8_BAR; PG8_MMA(1, 0, At, B0); PG8_MMA(1, 1, At, B1); PG8_BAR; PG8_SCHED;
        }
        if constexpr (ALIGN_EPI) { if (wr == 0) PG8_BAR; }
        E(acc, cur, wr, wc, fr, fq);
        if (!has_next) break;
#pragma unroll
        for (int a = 0; a < 2; ++a)
#pragma unroll
            for (int b = 0; b < 2; ++b)
#pragma unroll
                for (int m = 0; m < 4; ++m)
#pragma unroll
                    for (int n = 0; n < 2; ++n) acc[a][b][m][n] = (f32x4){zf, zf, zf, zf};
        cur = nxt; cA = nA; cB = nB; ++ui;
#pragma unroll
        for (int _h = 0; _h < 2; ++_h)
#pragma unroll
            for (int _i = 0; _i < 2; ++_i) oc[_h][_i] = on[_h][_i];
        if constexpr (ALIGN_EPI) { if (wr == 1) PG8_BAR; }
    }
    PG8_WAIT_V(0);
    if constexpr (!ALIGN_EPI) { if (wr == 0) PG8_BAR; }
    PG8_BAR;
#undef PG8_AOFF
#undef PG8_SA
#undef PG8_SB
#undef PG8_STAGE
#undef PG8_LDA
#undef PG8_LDB
#undef PG8_MMA
#undef PG8_WAIT_V
#undef PG8_WAIT_L
#undef PG8_BAR
#undef PG8_SCHED
}
}
#include <hip/hip_bf16.h>
namespace attn_body {
using bf16=__hip_bfloat16;
using bf16x8=__attribute__((ext_vector_type(8)))short;
using s16x4=__attribute__((ext_vector_type(4)))short;
using f32x16=__attribute__((ext_vector_type(16)))float;
using f32x4a=__attribute__((ext_vector_type(4)))float;
using u32x4=__attribute__((ext_vector_type(4)))unsigned;
constexpr int SEQ=8192,D=64,DM=3584,OD=1024;
constexpr int NW=8,QBLK=32,QB=QBLK*NW,KVBLK=64,NQB=SEQ/QB;
__device__ __forceinline__ int crow(int r,int hi){return (r&3)+8*(r>>2)+4*hi;}
#define SBAR() __builtin_amdgcn_sched_barrier(0)
__device__ __forceinline__ void cmask(f32x16&p0,f32x16&p1,int jb,int qrel,int hi){
  const float NEG=-INFINITY; int kb=64*jb+4*hi;
  #pragma unroll
  for(int r=0;r<16;++r){int kv=kb+(r&3)+8*(r>>2); if(kv>qrel)p0[r]=NEG; if(kv+32>qrel)p1[r]=NEG;}
}
constexpr int NSLOT=3, SLOTB=8192;
constexpr int LDS_K=0, LDS_V=NSLOT*SLOTB, LDS_WS=2*NSLOT*SLOTB, LDS_OST=LDS_WS+NW*64*4, LDS_TAB=LDS_OST+NW*4096, LDS_CT=LDS_TAB+SEQ*4, LDS_BYTES=LDS_CT+1024;
constexpr float LOG2E=1.4426950408889634f;
constexpr float C2=0.125f*LOG2E;
__device__ __forceinline__ void glds16(const void*gsrc,unsigned lds_dst){unsigned keep;
  asm volatile("s_mov_b32 %0, m0\n\ts_mov_b32 m0, %2\n\ts_nop 0\n\tglobal_load_lds_dwordx4 %1, off\n\ts_mov_b32 m0, %0":"=&s"(keep):"v"(gsrc),"s"(lds_dst):"memory");}
__device__ __forceinline__ float max3f(float a,float b,float c){float r;asm("v_max3_f32 %0, %1, %2, %3":"=v"(r):"v"(a),"v"(b),"v"(c));return r;}
__device__ __forceinline__ float max2f(float a,float b){float r;asm("v_max_f32_e32 %0, %1, %2":"=v"(r):"v"(a),"v"(b));return r;}
__device__ __forceinline__ float fadd_s(float a,float b){float r;asm("v_add_f32_e32 %0, %1, %2":"=v"(r):"v"(a),"v"(b));return r;}
__device__ __forceinline__ float fsub_s(float a,float b){float r;asm("v_sub_f32_e32 %0, %1, %2":"=v"(r):"v"(a),"v"(b));return r;}
typedef float f32x2_t __attribute__((ext_vector_type(2))); typedef __bf16 bf16x2_t __attribute__((ext_vector_type(2)));
__device__ __forceinline__ unsigned cvtpk_s(float lo,float hi){f32x2_t v={lo,hi};bf16x2_t b=__builtin_convertvector(v,bf16x2_t);return __builtin_bit_cast(unsigned,b);}
__device__ __forceinline__ float bf_lo(unsigned w){return __uint_as_float(w<<16);} __device__ __forceinline__ float bf_hi(unsigned w){return __uint_as_float(w&0xffff0000u);}
#define WAIT_BAR(N) asm volatile("s_waitcnt vmcnt(" #N ") lgkmcnt(0)\n\ts_barrier":::"memory")

__device__ __forceinline__ void qkt(f32x16&p0,f32x16&p1,const char*Kslot,const bf16x8*qr,const f32x16&negm,int r32,int hi){
  const char*kb=Kslot+hi*1024+r32*16;
  #pragma unroll
  for(int d0=0;d0<4;++d0){
    const bf16x8 b0=*reinterpret_cast<const bf16x8*>(kb+d0*2048);
    const bf16x8 b1=*reinterpret_cast<const bf16x8*>(kb+d0*2048+512);
    if(d0==0){p0=__builtin_amdgcn_mfma_f32_32x32x16_bf16(b0,qr[0],negm,0,0,0);p1=__builtin_amdgcn_mfma_f32_32x32x16_bf16(b1,qr[0],negm,0,0,0);}
    else{p0=__builtin_amdgcn_mfma_f32_32x32x16_bf16(b0,qr[d0],p0,0,0,0);p1=__builtin_amdgcn_mfma_f32_32x32x16_bf16(b1,qr[d0],p1,0,0,0);}}
}
typedef __attribute__((address_space(3))) const char* lds_cptr;
typedef short v4i16_t __attribute__((ext_vector_type(4)));
__device__ __forceinline__ void kload8(bf16x8*kf,lds_cptr kp){
  kf[0]=*(const __attribute__((address_space(3))) bf16x8*)(kp);      kf[1]=*(const __attribute__((address_space(3))) bf16x8*)(kp+512);
  kf[2]=*(const __attribute__((address_space(3))) bf16x8*)(kp+2048); kf[3]=*(const __attribute__((address_space(3))) bf16x8*)(kp+2560);
  kf[4]=*(const __attribute__((address_space(3))) bf16x8*)(kp+4096); kf[5]=*(const __attribute__((address_space(3))) bf16x8*)(kp+4608);
  kf[6]=*(const __attribute__((address_space(3))) bf16x8*)(kp+6144); kf[7]=*(const __attribute__((address_space(3))) bf16x8*)(kp+6656);
}
__device__ __forceinline__ void kload2(bf16x8*kf,lds_cptr kp,int j){ kf[2*j]=*(const __attribute__((address_space(3))) bf16x8*)(kp+j*2048); kf[2*j+1]=*(const __attribute__((address_space(3))) bf16x8*)(kp+j*2048+512); }
__device__ __forceinline__ s16x4 vtr(lds_cptr p){ return __builtin_bit_cast(s16x4,__builtin_amdgcn_ds_read_tr16_b64_v4i16((__attribute__((address_space(3))) v4i16_t*)p)); }
__device__ __forceinline__ float rowmax(const f32x16&p0,const f32x16&p1){
  float a=max3f(p0[0],p0[1],p1[0]),b=max3f(p0[2],p0[3],p1[1]);a=max3f(a,p1[2],p1[3]);
  #pragma unroll
  for(int r=4;r<16;r+=4){a=max3f(a,p0[r],p0[r+1]);b=max3f(b,p0[r+2],p0[r+3]);a=max3f(a,p1[r],p1[r+1]);b=max3f(b,p1[r+2],p1[r+3]);}
  const float m=max2f(a,b);
  auto rr=__builtin_amdgcn_permlane32_swap(__float_as_uint(m),__float_as_uint(m),false,false);
  return max2f(__uint_as_float(rr[0]),__uint_as_float(rr[1]));
}
__device__ __forceinline__ void pv(f32x16*o,int vb,bf16x8 pa0,bf16x8 pa1,bf16x8 pa2,bf16x8 pa3){
  #pragma unroll
  for(int d0=0;d0<2;++d0){s16x4 lo[4],hi[4];
    #pragma unroll
    for(int ks=0;ks<4;++ks){
      asm volatile("ds_read_b64_tr_b16 %0,%1 offset:%c2":"=&v"(lo[ks]):"v"(vb),"i"(d0*4096+ks*1024):"memory");
      asm volatile("ds_read_b64_tr_b16 %0,%1 offset:%c2":"=&v"(hi[ks]):"v"(vb),"i"(d0*4096+ks*1024+512):"memory");}
    asm volatile("s_waitcnt lgkmcnt(0)":::"memory");SBAR();
    #define PK(k) (bf16x8){lo[k][0],lo[k][1],lo[k][2],lo[k][3],hi[k][0],hi[k][1],hi[k][2],hi[k][3]}
    o[d0]=__builtin_amdgcn_mfma_f32_32x32x16_bf16(pa0,PK(0),o[d0],0,0,0);
    o[d0]=__builtin_amdgcn_mfma_f32_32x32x16_bf16(pa1,PK(1),o[d0],0,0,0);
    o[d0]=__builtin_amdgcn_mfma_f32_32x32x16_bf16(pa2,PK(2),o[d0],0,0,0);
    o[d0]=__builtin_amdgcn_mfma_f32_32x32x16_bf16(pa3,PK(3),o[d0],0,0,0);
    #undef PK
  }
}
__device__ __forceinline__ void head_norm_store(const bf16*stg,bf16*Ow,const bf16*gate,const float*g,int lane){
  const int ch=lane&7;
  const f32x4a g0=*(const f32x4a*)(g+ch*8), g1=*(const f32x4a*)(g+ch*8+4);
  #pragma unroll
  for(int i=0;i<4;++i){const int row=i*8+(lane>>3);
    const u32x4 v=*(const u32x4*)(stg+row*64+ch*8);
    float x[8]={bf_lo(v[0]),bf_hi(v[0]),bf_lo(v[1]),bf_hi(v[1]),bf_lo(v[2]),bf_hi(v[2]),bf_lo(v[3]),bf_hi(v[3])};
    float ss=0.f;
    #pragma unroll
    for(int j=0;j<8;++j)ss+=x[j]*x[j];
    ss+=__shfl_xor(ss,1);ss+=__shfl_xor(ss,2);ss+=__shfl_xor(ss,4);
    const float rs=1.0f/sqrtf(ss*(1.0f/64.0f)+1e-6f);
    float gm[8]={g0[0],g0[1],g0[2],g0[3],g1[0],g1[1],g1[2],g1[3]};
    if(gate){const u32x4 gv=*(const u32x4*)(gate+(long)row*DM+ch*8);
      float t[8]={bf_lo(gv[0]),bf_hi(gv[0]),bf_lo(gv[1]),bf_hi(gv[1]),bf_lo(gv[2]),bf_hi(gv[2]),bf_lo(gv[3]),bf_hi(gv[3])};
      #pragma unroll
      for(int j=0;j<8;++j)gm[j]*=__builtin_amdgcn_rcpf(1.0f+__builtin_amdgcn_exp2f(-LOG2E*t[j]));}
    u32x4 w;
    w[0]=cvtpk_s(x[0]*rs*gm[0],x[1]*rs*gm[1]);w[1]=cvtpk_s(x[2]*rs*gm[2],x[3]*rs*gm[3]);w[2]=cvtpk_s(x[4]*rs*gm[4],x[5]*rs*gm[5]);w[3]=cvtpk_s(x[6]*rs*gm[6],x[7]*rs*gm[7]);
    *(u32x4*)(Ow+(long)row*OD+ch*8)=w;}
}

template<int THRL> __device__ __forceinline__ void fox_unit(int b,int h,int qb,const bf16*Q,const bf16*__restrict__ K,const bf16*__restrict__ V,const bf16*__restrict__ G,bf16*O,
                                                            const float*__restrict__ floc,const float*__restrict__ ct,const float*__restrict__ gn,char*shm){
  int tid_=threadIdx.x; asm volatile("":"+v"(tid_));
  const int tid=tid_,lane=tid&63,r32=lane&31,hi=lane>>5; const int wid=__builtin_amdgcn_readfirstlane(tid>>6);
  const long rowbase=(long)b*SEQ; const int q0=qb*QB;
  const bf16*Qw=Q+(rowbase+q0+wid*QBLK)*DM+h*D;
  const bf16*Kh=K+rowbase*DM+h*D,*Vh=V+rowbase*DM+h*D;
  const unsigned lds0=(unsigned)(uintptr_t)shm;
  float*wsf=(float*)(shm+LDS_WS)+wid*64;
  const bf16*ksrc=Kh+(long)lane*DM+wid*8;
  const bf16*vsrc=Vh+(long)(16*(wid&3)+(lane>>2))*DM+(wid>>2)*32+(lane&3)*8;
  const unsigned kdst=lds0+LDS_K+wid*1024, vdst=lds0+LDS_V+wid*1024;
  #define DMA_K(t,slot) glds16(ksrc+(long)(t)*KVBLK*DM,(unsigned)__builtin_amdgcn_readfirstlane(kdst+(slot)))
  #define DMA_V(t,slot) glds16(vsrc+(long)(t)*KVBLK*DM,(unsigned)__builtin_amdgcn_readfirstlane(vdst+(slot)))
  const int vb0=(int)(lds0+LDS_V)+((lane>>4)&1)*32+(lane&3)*8+(4*hi+((lane&15)>>2))*64;
  const char*Kbase=shm+LDS_K; bf16x8 kf[8];
  const lds_cptr shm3=(lds_cptr)shm; const lds_cptr kp0=shm3+LDS_K+hi*1024+r32*16; const lds_cptr vp0=shm3+LDS_V+((lane>>4)&1)*32+(lane&3)*8+(4*hi+((lane&15)>>2))*64;
  const int NT=(q0+QB)/KVBLK;
  DMA_K(0,0);DMA_V(0,0);DMA_K(1,SLOTB);
  float*cts=(float*)(shm+LDS_CT); float*offs=cts+128; float*tab=(float*)(shm+LDS_TAB);
  if(tid<128)cts[tid]=ct[tid];
  __syncthreads();
  if(tid<128){const int c=tid,c0=4*qb; float a=0.f; if(c<c0){for(int k=c;k<c0;++k)a-=cts[k];}else{for(int k=c0;k<c;++k)a+=cts[k];} offs[c]=a;}
  __syncthreads();
  for(int s=tid;s<q0+QB;s+=512)tab[s]=-(offs[s>>6]+floc[s])*LOG2E;
  const float ft2=(offs[(q0+wid*QBLK+r32)>>6]+floc[q0+wid*QBLK+r32])*LOG2E;
  __syncthreads();
  const __attribute__((address_space(3))) float*tab3=(const __attribute__((address_space(3))) float*)(shm3+LDS_TAB)+r32;
  float qa=hi?ft2:1.f;
  #define KA(dst,t,half) do{ const float e_=tab3[(t)*64+(half)*32]; dst=hi?1.f:e_; }while(0)
  #define BIASMF(C,ka) __builtin_amdgcn_mfma_f32_32x32x2f32(ka,qa,C,0,0,0)
  bf16x8 qr[4];
  #pragma unroll
  for(int d0=0;d0<4;++d0)qr[d0]=*reinterpret_cast<const bf16x8*>(&Qw[(long)r32*DM+d0*16+hi*8]);
  float mhat=0.f,l_reg=0.f;f32x16 o[2];o[0]=f32x16{};o[1]=f32x16{};const f32x16 zero16=f32x16{};
  const int qrel=wid*QBLK+r32;
  #define CMASK(P0,P1,t) do{int jb_=(t)-(NT-4); if(jb_>=0)cmask(P0,P1,jb_,qrel,hi);}while(0)
  bool resc=false;
  #define START(P0,P1) do{ const float rm=rowmax(P0,P1); resc=false; \
    { const float dl=rm; mhat=fadd_s(mhat,dl); \
      _Pragma("unroll") for(int r=0;r<16;++r){P0[r]=fsub_s(P0[r],dl);P1[r]=fsub_s(P1[r],dl);} \
      qa=hi?(ft2-mhat):1.f; } \
    _Pragma("unroll") for(int r=0;r<16;++r)P0[r]=__builtin_amdgcn_exp2f(P0[r]); }while(0)
  #define RESC() do{ if(resc){ asm volatile("s_waitcnt lgkmcnt(0)":::"memory"); \
      _Pragma("unroll") for(int d_=0;d_<2;++d_) _Pragma("unroll") for(int r=0;r<16;++r)o[d_][r]*=wsf[crow(r,hi)]; } }while(0)
  f32x16 pA0,pA1,pB0,pB1;
  int sl_prev=0,sl_cur=0,sl_next=SLOTB;
  #define ROT() do{sl_prev=sl_cur;sl_cur=sl_next;sl_next=(sl_next==(NSLOT-1)*SLOTB)?0:sl_next+SLOTB;}while(0)
  DMA_K(2,2*SLOTB);
  WAIT_BAR(3);
  { float ka0,ka1; KA(ka0,0,0); KA(ka1,0,1);
    qkt(pA0,pA1,Kbase,qr,zero16,r32,hi);
    pA0=BIASMF(pA0,ka0); pA1=BIASMF(pA1,ka1); }
  asm volatile("s_nop 15\n\ts_nop 7":"+v"(pA0),"+v"(pA1));CMASK(pA0,pA1,0);
  START(pA0,pA1);
  _Pragma("unroll") for(int r=0;r<16;++r)pA1[r]=__builtin_amdgcn_exp2f(pA1[r]);
  WAIT_BAR(0);
  DMA_K(3,0);DMA_V(1,SLOTB);
  ROT();
  kload8(kf,kp0+sl_cur);
  WAIT_BAR(2);
  s16x4 vlo[8],vhi[8]; u32x4 pw0,pw1,pw2,pw3;
  #define PKW(P,B) cvtpk_s(P[B],P[B+1])
  #define PAF(k) __builtin_bit_cast(bf16x8,pw##k)
  #define VFR(i) (bf16x8){vlo[i][0],vlo[i][1],vlo[i][2],vlo[i][3],vhi[i][0],vhi[i][1],vhi[i][2],vhi[i][3]}
  #define PIN(x) asm volatile("":"+v"(x))
  #define MX3(a,b,c) __builtin_fmaxf(__builtin_fmaxf((a),(b)),(c))
  #define GAPA(MF,A0,A1,A2,A3,W0,W1,PW) do{ MF; sacc+=A0; sacc+=A1; sacc+=A2; sacc+=A3; PIN(sacc); W0; W1; PIN(PW); SBAR(); }while(0)
  #define EX(v) __builtin_amdgcn_exp2f(v)
  #define GAPB(MF,X,B) do{ MF; X[B]=EX(X[B]); X[B+1]=EX(X[B+1]); X[B+2]=EX(X[B+2]); X[B+3]=EX(X[B+3]); PIN(X); SBAR(); }while(0)
  #define VRD(i) do{ vlo[i]=vtr(vp_+(((i)>>2)*4096+((i)&3)*1024)); vhi[i]=vtr(vp_+(((i)>>2)*4096+((i)&3)*1024+512)); }while(0)
  #define KRD(G,j) do{ if(G){ kload2(kf,kp0+sl_next,j); SBAR(); } }while(0)
  #define STEP(C0,C1,P0,P1,t,GK,GV,GL) do{ SBAR(); \
    const lds_cptr vp_=vp0+sl_prev; float ka0_,ka1_; KA(ka0_,t,0); KA(ka1_,t,1); \
    VRD(0); SBAR(); float sacc=(P0[0]+P0[1]); \
    GAPA(C0=__builtin_amdgcn_mfma_f32_32x32x16_bf16(kf[0],qr[0],zero16,0,0,0), P0[2],P0[3],P0[4],P0[5],     pw0[0]=PKW(P0,0), pw0[1]=PKW(P0,2), pw0); \
    VRD(4); SBAR(); GAPA(C1=__builtin_amdgcn_mfma_f32_32x32x16_bf16(kf[1],qr[0],zero16,0,0,0), P0[6],P0[7],P0[8],P0[9],     pw0[2]=PKW(P0,4), pw0[3]=PKW(P0,6), pw0); \
    VRD(1); SBAR(); GAPA(C0=__builtin_amdgcn_mfma_f32_32x32x16_bf16(kf[2],qr[1],C0,0,0,0),   P0[10],P0[11],P0[12],P0[13], pw1[0]=PKW(P0,8), pw1[1]=PKW(P0,10), pw1); \
    VRD(5); SBAR(); GAPA(C1=__builtin_amdgcn_mfma_f32_32x32x16_bf16(kf[3],qr[1],C1,0,0,0),   P0[14],P0[15],P1[0],P1[1],   pw1[2]=PKW(P0,12),pw1[3]=PKW(P0,14), pw1); \
    VRD(2); SBAR(); GAPA(C0=__builtin_amdgcn_mfma_f32_32x32x16_bf16(kf[4],qr[2],C0,0,0,0),   P1[2],P1[3],P1[4],P1[5],     pw2[0]=PKW(P1,0), pw2[1]=PKW(P1,2), pw2); \
    VRD(6); SBAR(); GAPA(C1=__builtin_amdgcn_mfma_f32_32x32x16_bf16(kf[5],qr[2],C1,0,0,0),   P1[6],P1[7],P1[8],P1[9],     pw2[2]=PKW(P1,4), pw2[3]=PKW(P1,6), pw2); \
    VRD(3); SBAR(); GAPA(C0=__builtin_amdgcn_mfma_f32_32x32x16_bf16(kf[6],qr[3],C0,0,0,0),   P1[10],P1[11],P1[12],P1[13], pw3[0]=PKW(P1,8), pw3[1]=PKW(P1,10), pw3); \
    VRD(7); SBAR(); GAPA(C1=__builtin_amdgcn_mfma_f32_32x32x16_bf16(kf[7],qr[3],C1,0,0,0),   P1[14],P1[15],0.f,0.f,       pw3[2]=PKW(P1,12),pw3[3]=PKW(P1,14), pw3); \
    C0=BIASMF(C0,ka0_); C1=BIASMF(C1,ka1_); SBAR(); \
    l_reg+=sacc; \
    if(GK){DMA_K((t)+3,sl_cur);} if(GV){DMA_V((t)+1,sl_next);} \
    CMASK(C0,C1,t); \
    { float a=MX3(C0[0],C0[1],C1[0]),b=MX3(C0[2],C0[3],C1[1]); a=MX3(a,C1[2],C1[3]); \
      _Pragma("unroll") for(int r=4;r<16;r+=4){a=MX3(a,C0[r],C0[r+1]);b=MX3(b,C0[r+2],C0[r+3]);a=MX3(a,C1[r],C1[r+1]);b=MX3(b,C1[r+2],C1[r+3]);} \
      float rm=__builtin_fmaxf(a,b); { auto rr=__builtin_amdgcn_permlane32_swap(__float_as_uint(rm),__float_as_uint(rm),false,false); rm=__builtin_fmaxf(__uint_as_float(rr[0]),__uint_as_float(rr[1])); } \
      resc=false; \
      if(__builtin_expect(__any(rm>(float)THRL),0)){ const float dl=__builtin_fmaxf(rm,0.f); mhat+=dl; \
        _Pragma("unroll") for(int r=0;r<16;++r){C0[r]-=dl;C1[r]-=dl;} \
        qa=hi?(ft2-mhat):1.f; \
        const float f=__builtin_amdgcn_exp2f(-dl); l_reg*=f; if(hi==0)wsf[r32]=f; resc=true; } } \
    SBAR(); \
    GAPB(o[0]=__builtin_amdgcn_mfma_f32_32x32x16_bf16(PAF(0),VFR(0),o[0],0,0,0), C0,0); \
    GAPB(o[1]=__builtin_amdgcn_mfma_f32_32x32x16_bf16(PAF(0),VFR(4),o[1],0,0,0), C0,4); \
    KRD(GL,0); GAPB(o[0]=__builtin_amdgcn_mfma_f32_32x32x16_bf16(PAF(1),VFR(1),o[0],0,0,0), C0,8); \
    KRD(GL,1); GAPB(o[1]=__builtin_amdgcn_mfma_f32_32x32x16_bf16(PAF(1),VFR(5),o[1],0,0,0), C0,12); \
    KRD(GL,2); GAPB(o[0]=__builtin_amdgcn_mfma_f32_32x32x16_bf16(PAF(2),VFR(2),o[0],0,0,0), C1,0); \
    KRD(GL,3); GAPB(o[1]=__builtin_amdgcn_mfma_f32_32x32x16_bf16(PAF(2),VFR(6),o[1],0,0,0), C1,4); \
    GAPB(o[0]=__builtin_amdgcn_mfma_f32_32x32x16_bf16(PAF(3),VFR(3),o[0],0,0,0), C1,8); \
    GAPB(o[1]=__builtin_amdgcn_mfma_f32_32x32x16_bf16(PAF(3),VFR(7),o[1],0,0,0), C1,12); \
    }while(0)
  int t=1;
  #undef CMASK
  #define CMASK(P0,P1,t) do{}while(0)
  for(;t+5<NT;t+=2){
    STEP(pB0,pB1,pA0,pA1,t,true,true,true);     WAIT_BAR(2); RESC(); ROT();
    STEP(pA0,pA1,pB0,pB1,t+1,true,true,true);   WAIT_BAR(2); RESC(); ROT();
  }
  #undef CMASK
  #define CMASK(P0,P1,t) do{int jb_=(t)-(NT-4); if(jb_>=0)cmask(P0,P1,jb_,qrel,hi);}while(0)
  #define ENDW(tt) do{ if((tt)+3<NT){WAIT_BAR(2);} else if((tt)+2<NT){WAIT_BAR(1);} else {WAIT_BAR(0);} }while(0)
  for(;t+1<NT;t+=2){
    STEP(pB0,pB1,pA0,pA1,t,(t+3<NT),(t+1<NT),(t+1<NT));       ENDW(t);   RESC(); ROT();
    STEP(pA0,pA1,pB0,pB1,t+1,(t+4<NT),(t+2<NT),(t+2<NT));     ENDW(t+1); RESC(); ROT();
  }
  STEP(pB0,pB1,pA0,pA1,NT-1,false,false,false); RESC();
  { float sacc=pB0[0]+pB0[1]; _Pragma("unroll") for(int r=2;r<16;++r)sacc+=pB0[r]; _Pragma("unroll") for(int r=0;r<16;++r)sacc+=pB1[r]; l_reg+=sacc;
    pw0=(u32x4){PKW(pB0,0),PKW(pB0,2),PKW(pB0,4),PKW(pB0,6)};pw1=(u32x4){PKW(pB0,8),PKW(pB0,10),PKW(pB0,12),PKW(pB0,14)};pw2=(u32x4){PKW(pB1,0),PKW(pB1,2),PKW(pB1,4),PKW(pB1,6)};pw3=(u32x4){PKW(pB1,8),PKW(pB1,10),PKW(pB1,12),PKW(pB1,14)};
    SBAR(); pv(o,vb0+sl_cur,PAF(0),PAF(1),PAF(2),PAF(3)); }
  #undef PKW
  #undef PAF
  #undef VFR
  #undef PIN
  #undef MX3
  #undef GAPA
  #undef GAPB
  #undef EX
  #undef VRD
  #undef KRD
  #undef STEP
  #undef ENDW
  #undef KA
  #undef BIASMF
  {auto rr=__builtin_amdgcn_permlane32_swap(__float_as_uint(l_reg),__float_as_uint(l_reg),false,false);l_reg=__uint_as_float(rr[0])+__uint_as_float(rr[1]);}
  if(hi==0)wsf[32+r32]=l_reg;asm volatile("s_waitcnt lgkmcnt(0)":::"memory");
  float rli[16];
  #pragma unroll
  for(int r=0;r<16;++r)rli[r]=__builtin_amdgcn_rcpf(wsf[32+crow(r,hi)]);
  { bf16*stg=(bf16*)(shm+LDS_OST)+wid*2048;
    #pragma unroll
    for(int r=0;r<16;++r){const int orow=crow(r,hi);
      #pragma unroll
      for(int d0=0;d0<2;++d0)stg[orow*64+d0*32+r32]=__float2bfloat16(o[d0][r]*rli[r]);}
    asm volatile("s_waitcnt lgkmcnt(0)":::"memory");
    head_norm_store(stg,O+(rowbase+q0+wid*QBLK)*OD+h*D,G+(rowbase+q0+wid*QBLK)*DM+h*D,gn+h*D,lane); }
  asm volatile("s_waitcnt lgkmcnt(0)\n\ts_barrier":::"memory");
  #undef DMA_K
  #undef DMA_V
  #undef CMASK
  #undef START
  #undef RESC
  #undef ROT
}

__device__ __forceinline__ void sb_wave(int b,int h,int qw,const bf16*Q,const bf16*__restrict__ K,const bf16*__restrict__ V,bf16*O,const float*__restrict__ gn,char*slot,int lane_){
  int lane=lane_; asm volatile("":"+v"(lane));
  const int r32=lane&31,hi=lane>>5;
  const long rowbase=(long)b*SEQ;
  const bf16*Qw=Q+(rowbase+qw)*DM+h*D;
  const bf16*Kh=K+rowbase*DM+h*D,*Vh=V+rowbase*DM+h*D;
  const unsigned lds0=(unsigned)(uintptr_t)slot;
  const int vb0=(int)(lds0+8192)+((lane>>4)&1)*32+(lane&3)*8+(4*hi+((lane&15)>>2))*64;
  bf16x8 qr[4];
  #pragma unroll
  for(int d0=0;d0<4;++d0)qr[d0]=*reinterpret_cast<const bf16x8*>(&Qw[(long)r32*DM+d0*16+hi*8]);
  f32x16 o[2];o[0]=f32x16{};o[1]=f32x16{};
  const f32x16 zero=f32x16{};
  float carry=0.f;
  const int qabs=qw+r32;
  for(int j=(qw+30)>>6;j>=0;--j){
    asm volatile("s_waitcnt lgkmcnt(0)":::"memory");
    #pragma unroll
    for(int w8=0;w8<8;++w8)glds16(Kh+(long)(j*KVBLK+lane)*DM+w8*8,(unsigned)__builtin_amdgcn_readfirstlane(lds0+w8*1024));
    #pragma unroll
    for(int w8=0;w8<8;++w8)glds16(Vh+(long)(j*KVBLK+16*(w8&3)+(lane>>2))*DM+(w8>>2)*32+(lane&3)*8,(unsigned)__builtin_amdgcn_readfirstlane(lds0+8192+w8*1024));
    asm volatile("s_waitcnt vmcnt(0)":::"memory");
    f32x16 p0,p1;
    qkt(p0,p1,slot,qr,zero,r32,hi);
    const int kb=64*j+4*hi;
    float lk0[16],lk1[16];
    #pragma unroll
    for(int r=0;r<16;++r){
      const int kv=kb+(r&3)+8*(r>>2);
      { const float z=p0[r]; const float t=__builtin_amdgcn_logf(1.0f+__builtin_amdgcn_exp2f(-__builtin_fabsf(z))); const bool ok=kv<qabs;
        p0[r]=ok?(__builtin_fminf(z,0.f)-t):-INFINITY; lk0[r]=ok?(__builtin_fminf(-z,0.f)-t):0.f; }
      { const float z=p1[r]; const float t=__builtin_amdgcn_logf(1.0f+__builtin_amdgcn_exp2f(-__builtin_fabsf(z))); const bool ok=(kv+32)<qabs;
        p1[r]=ok?(__builtin_fminf(z,0.f)-t):-INFINITY; lk1[r]=ok?(__builtin_fminf(-z,0.f)-t):0.f; }
    }
    float gs[8],og[8];
    #pragma unroll
    for(int g=0;g<4;++g){gs[g]=(lk0[4*g]+lk0[4*g+1])+(lk0[4*g+2]+lk0[4*g+3]); gs[g+4]=(lk1[4*g]+lk1[4*g+1])+(lk1[4*g+2]+lk1[4*g+3]);}
    #pragma unroll
    for(int g=0;g<8;++g)og[g]=__shfl_xor(gs[g],32);
    float run=carry;
    #pragma unroll
    for(int g=7;g>=0;--g){
      const float base=run+(hi?0.f:og[g]);
      run+=gs[g]+og[g];
      if(g>=4){const int q=4*(g-4); const float l3=base,l2=l3+lk1[q+3],l1=l2+lk1[q+2],l0=l1+lk1[q+1];
        p1[q]=__builtin_amdgcn_exp2f(p1[q]+l0);p1[q+1]=__builtin_amdgcn_exp2f(p1[q+1]+l1);p1[q+2]=__builtin_amdgcn_exp2f(p1[q+2]+l2);p1[q+3]=__builtin_amdgcn_exp2f(p1[q+3]+l3);}
      else{const int q=4*g; const float l3=base,l2=l3+lk0[q+3],l1=l2+lk0[q+2],l0=l1+lk0[q+1];
        p0[q]=__builtin_amdgcn_exp2f(p0[q]+l0);p0[q+1]=__builtin_amdgcn_exp2f(p0[q+1]+l1);p0[q+2]=__builtin_amdgcn_exp2f(p0[q+2]+l2);p0[q+3]=__builtin_amdgcn_exp2f(p0[q+3]+l3);}
    }
    carry=run;
    u32x4 pw0,pw1,pw2,pw3;
    pw0=(u32x4){cvtpk_s(p0[0],p0[1]),cvtpk_s(p0[2],p0[3]),cvtpk_s(p0[4],p0[5]),cvtpk_s(p0[6],p0[7])};
    pw1=(u32x4){cvtpk_s(p0[8],p0[9]),cvtpk_s(p0[10],p0[11]),cvtpk_s(p0[12],p0[13]),cvtpk_s(p0[14],p0[15])};
    pw2=(u32x4){cvtpk_s(p1[0],p1[1]),cvtpk_s(p1[2],p1[3]),cvtpk_s(p1[4],p1[5]),cvtpk_s(p1[6],p1[7])};
    pw3=(u32x4){cvtpk_s(p1[8],p1[9]),cvtpk_s(p1[10],p1[11]),cvtpk_s(p1[12],p1[13]),cvtpk_s(p1[14],p1[15])};
    pv(o,vb0,__builtin_bit_cast(bf16x8,pw0),__builtin_bit_cast(bf16x8,pw1),__builtin_bit_cast(bf16x8,pw2),__builtin_bit_cast(bf16x8,pw3));
    if(__all(carry<-152.0f))break;
  }
  asm volatile("s_waitcnt lgkmcnt(0)":::"memory");
  { bf16*stg=(bf16*)slot;
    #pragma unroll
    for(int r=0;r<16;++r){const int orow=crow(r,hi);
      #pragma unroll
      for(int d0=0;d0<2;++d0)stg[orow*64+d0*32+r32]=__float2bfloat16(o[d0][r]);}
    asm volatile("s_waitcnt lgkmcnt(0)":::"memory");
    head_norm_store(stg,O+(rowbase+qw)*OD+h*D,nullptr,gn+h*D,lane); }
  asm volatile("s_waitcnt lgkmcnt(0)":::"memory");
}
#undef SBAR
#undef WAIT_BAR
}
namespace mk {
constexpr int NWAVES = 8;
constexpr int BATCH = 2, T = 8192, D = 1024, M = BATCH * T, NPROJ = 3584, NIN = 3592, NE = 16, DEPTH = 4, NMODC = 6144;
constexpr int PC_FQ = 0, PC_FK = 512, PC_FV = 1024, PC_FG = 1536, PC_SQ = 2048, PC_SK = 2560, PC_SV = 3072;
constexpr int MO_SHA = 0, MO_SCA = 1024, MO_GA = 2048, MO_SHF = 3072, MO_SCF = 4096, MO_GF = 5120;
constexpr float ALPHA = 1.6817928305074292f, LN_EPS = 1e-5f;
constexpr int HB_ROWS = 36864;

constexpr size_t MiB = 1u << 20;
constexpr size_t WS_CTL = 0, CTL_ZERO_BYTES = 1 * MiB;
constexpr size_t WS_MOD = 1 * MiB, WS_FLOC = 2 * MiB, WS_CT = 2 * MiB + 768 * 1024, WS_LIST = 3 * MiB, WS_TOKS = 4 * MiB, WS_TOKW = 4 * MiB + 256 * 1024;
constexpr size_t WS_WIN = 8 * MiB, WS_WOUT = 36 * MiB, WS_WGU = 44 * MiB, WS_WD = 300 * MiB;
constexpr size_t WS_UA = 428 * MiB, WS_PQ = 460 * MiB, WS_OB = 572 * MiB, WS_YB = 604 * MiB, WS_X1 = 668 * MiB, WS_U2 = 732 * MiB, WS_HB = 764 * MiB, WS_YD = 836 * MiB, WS_XDBG = 908 * MiB, WS_END = 972 * MiB;
constexpr size_t WIN_L = (size_t)NPROJ * D * 2, WOUT_L = (size_t)D * D * 2, WGU_E = (size_t)2048 * D * 2, WGU_L = 16 * WGU_E, WD_E = (size_t)D * D * 2, WD_L = 16 * WD_E;
constexpr int CW_TMO = 0, CW_BAR = 4096, CW_CNT = 8192  , CW_CHK = 16384;

constexpr int RING_OFF = 0, RING_BYTES = 131072, LDSCTL_OFF = RING_BYTES, MISC_OFF = LDSCTL_OFF + 1024, LDS_BYTES = 147456;

#define GAS __attribute__((address_space(1)))
#define LAS __attribute__((address_space(3)))
typedef unsigned short bf16;
typedef unsigned v4u __attribute__((ext_vector_type(4)));
typedef float f32x4 __attribute__((ext_vector_type(4)));
typedef GAS unsigned gu32;
#define RLX_AGENT __ATOMIC_RELAXED, __HIP_MEMORY_SCOPE_AGENT
#define LDS_WAIT() asm volatile("s_waitcnt lgkmcnt(0)" ::: "memory")
__device__ __forceinline__ unsigned f2bf(float f) { unsigned u = __builtin_bit_cast(unsigned, f); return (u + 0x7fffu + ((u >> 16) & 1u)) >> 16; }
__device__ __forceinline__ unsigned pk2(float lo, float hi) { return f2bf(lo) | (f2bf(hi) << 16); }
__device__ __forceinline__ float bflo(unsigned w) { return __uint_as_float(w << 16); }
__device__ __forceinline__ float bfhi(unsigned w) { return __uint_as_float(w & 0xffff0000u); }

#define XB_TMO      128
#define XB_XCNT(j)  (256  + 64 * (j))
#define XB_XSUB(j)  (1280 + 64 * (j))
#define XB_XGEN(j)  (2304 + 64 * (j))
#define XB_TOP      3328
#define XB_TOPGEN   3392
#define XCD_BAR_WORDS 3456
#define XB_SPIN_CAP (1u << 18)
__device__ __forceinline__ unsigned xb_ld(unsigned* p)              { return __hip_atomic_load(p, __ATOMIC_RELAXED, __HIP_MEMORY_SCOPE_AGENT); }
__device__ __forceinline__ unsigned xb_add(unsigned* p, unsigned v) { return __hip_atomic_fetch_add(p, v, __ATOMIC_RELAXED, __HIP_MEMORY_SCOPE_AGENT); }
__device__ __forceinline__ unsigned xb_xcc_id() { return (unsigned)__builtin_amdgcn_s_getreg((3 << 11) | 20) & 0xFu; }
#define XB_SPIN(cond, bar) do { unsigned _sp = 0; while (cond) { __builtin_amdgcn_s_sleep(1); \
    if ((++_sp & 255u) == 0u) { if (xb_ld(&(bar)[XB_TMO])) break; if (_sp > XB_SPIN_CAP) { atomicAdd(&(bar)[XB_TMO], 1u); break; } } } } while (0)
struct XcdBarrier { unsigned* bar; unsigned x; volatile LAS unsigned* st; };
__device__ __forceinline__ XcdBarrier xcd_barrier_post(unsigned* bar, volatile LAS unsigned* st) {
    XcdBarrier b; b.bar = bar; b.x = xb_xcc_id(); b.st = st;
    if (threadIdx.x == 0) (void)xb_add(&bar[XB_XCNT(b.x)], 1u);
    return b;
}
__device__ __forceinline__ void xcd_barrier_complete(unsigned* bar, unsigned x, unsigned& nloc, unsigned& nx) {
    const unsigned G = gridDim.x * gridDim.y * gridDim.z;
    unsigned sum, cnt, mine, sp = 0u;
    for (;;) {
        sum = 0u; cnt = 0u; mine = 0u;
#pragma unroll
        for (unsigned j = 0; j < 16; ++j) { const unsigned c = xb_ld(&bar[XB_XCNT(j)]); sum += c; cnt += (c > 0u) ? 1u : 0u; mine = (j == x) ? c : mine; }
        if (sum == G) break;
        __builtin_amdgcn_s_sleep(1);
        if ((++sp & 255u) == 0u) { if (xb_ld(&bar[XB_TMO])) break; if (sp > XB_SPIN_CAP) { atomicAdd(&bar[XB_TMO], 1u); break; } }
    }
    nloc = mine > 0u ? mine : 1u; nx = cnt > 0u ? cnt : 1u;
}
__device__ __forceinline__ void xcd_barrier(const XcdBarrier& b) {
    asm volatile("s_waitcnt vmcnt(0)" ::: "memory");
    __syncthreads();
    if (threadIdx.x == 0) {
        unsigned* bar = b.bar;
        __builtin_amdgcn_s_waitcnt(0);
        unsigned nloc = b.st[0], nx = b.st[1];
        if (nloc == 0u) { xcd_barrier_complete(bar, b.x, nloc, nx); b.st[0] = nloc; b.st[1] = nx; }
        const unsigned old = xb_add(&bar[XB_XSUB(b.x)], 1u);
        const unsigned gen = old / nloc;
        if (old + 1u == (gen + 1u) * nloc) {
            __builtin_amdgcn_fence(__ATOMIC_RELEASE, "agent");
            asm volatile("s_waitcnt vmcnt(0)" ::: "memory");
            const unsigned og = xb_add(&bar[XB_TOP], 1u);
            const unsigned tg = og / nx;
            if (og + 1u == (tg + 1u) * nx) xb_add(&bar[XB_TOPGEN], 1u);
            else XB_SPIN(xb_ld(&bar[XB_TOPGEN]) == tg, bar);
            __builtin_amdgcn_fence(__ATOMIC_ACQUIRE, "agent");
            xb_add(&bar[XB_XGEN(b.x)], 1u);
            asm volatile("s_waitcnt vmcnt(0)" ::: "memory");
        } else {
            XB_SPIN(xb_ld(&bar[XB_XGEN(b.x)]) == gen, bar);
            __builtin_amdgcn_fence(__ATOMIC_ACQUIRE, "agent");
            asm volatile("s_waitcnt vmcnt(0)" ::: "memory");
        }
    }
    __syncthreads();
}

struct Args {
    const float *x, *c, *w_mod, *b_mod, *w_in, *b_forget, *out_norm_g, *w_out, *ln1_g, *ln1_b, *w_router, *b_router, *w_gate, *w_up, *w_down, *ln2_g, *ln2_b;
    float* out; unsigned char* ws; int ph_lo, ph_hi, use_bar, pad;
};
#define AS4 __attribute__((address_space(4)))
__device__ __forceinline__ void load_args(Args& a) {
#if defined(__HIP_DEVICE_COMPILE__)
    const AS4 unsigned long long* k = (const AS4 unsigned long long*)__builtin_amdgcn_kernarg_segment_ptr(); asm volatile("" : "+s"(k));
#define MK_LDP(i, field) a.field = (decltype(a.field))(GAS void*)k[i]
    MK_LDP(0, x); MK_LDP(1, c); MK_LDP(2, w_mod); MK_LDP(3, b_mod); MK_LDP(4, w_in); MK_LDP(5, b_forget); MK_LDP(6, out_norm_g); MK_LDP(7, w_out); MK_LDP(8, ln1_g); MK_LDP(9, ln1_b);
    MK_LDP(10, w_router); MK_LDP(11, b_router); MK_LDP(12, w_gate); MK_LDP(13, w_up); MK_LDP(14, w_down); MK_LDP(15, ln2_g); MK_LDP(16, ln2_b); MK_LDP(17, out); MK_LDP(18, ws);
#undef MK_LDP
    a.ph_lo = 0; a.ph_hi = 0; a.use_bar = 0; a.pad = 0;
#endif
}
constexpr int N_PHASES = 2 + 7 * DEPTH;

__device__ __forceinline__ float wave_sum(float v) {
#pragma unroll
    for (int o = 1; o < 64; o <<= 1) v += __shfl_xor(v, o);
    return v;
}
__device__ __forceinline__ float sel_m(float a0, float a1, unsigned long long m) { float r; asm("v_cndmask_b32 %0, %1, %2, %3" : "=v"(r) : "v"(a0), "v"(a1), "s"(m)); return r; }
__device__ __forceinline__ float log_sigmoid_f(float z) { return fminf(z, 0.f) - log1pf(expf(-fabsf(z))); }

__device__ __forceinline__ void tr_item(const float* __restrict__ W, int ldw, bf16* __restrict__ WT, LAS float* scr, int lane) {
#pragma unroll 8
    for (int i = 0; i < 32; ++i) { const int kk = 2 * i + (lane >> 5); scr[kk * 33 + (lane & 31)] = W[(size_t)kk * ldw + (lane & 31)]; }
    LDS_WAIT(); asm volatile("" ::: "memory");
    const int c = lane & 7;
#pragma unroll
    for (int j = 0; j < 4; ++j) { const int n = (lane >> 3) + 8 * j; const LAS float* s = scr + (8 * c) * 33 + n;
        v4u o; o.x = pk2(s[0 * 33], s[1 * 33]); o.y = pk2(s[2 * 33], s[3 * 33]); o.z = pk2(s[4 * 33], s[5 * 33]); o.w = pk2(s[6 * 33], s[7 * 33]);
        *(GAS v4u*)(WT + (size_t)n * D + 8 * c) = o; }
    LDS_WAIT(); asm volatile("" ::: "memory");
}
constexpr int IT_WINA = 1024, IT_WINB = 768, IT_WOUT = 512, IT_EXP = 1536, IT_LAYER = IT_WINA + IT_WINB + IT_WOUT + 16 * IT_EXP;
__device__ __forceinline__ void p0_weights(LAS unsigned char* lds, int gw, int NGW, int wave, int lane) {
    Args a; load_args(a);
    LAS float* scr = (LAS float*)(lds + RING_OFF + 32768 + wave * 8704);
    unsigned char* ws = a.ws;
    for (int it = gw; it < DEPTH * IT_LAYER; it += NGW) {
        const int l = it / IT_LAYER; int r = it % IT_LAYER;
        if (r < IT_WINA) { const int kb = r / 64, nb = r % 64; tr_item(a.w_in + (size_t)l * D * NIN + (size_t)(64 * kb) * NIN + 32 * nb, NIN, (bf16*)(ws + WS_WIN + l * WIN_L) + (size_t)(32 * nb) * D + 64 * kb, scr, lane); continue; }
        r -= IT_WINA;
        if (r < IT_WINB) { const int kb = r / 48, nb = r % 48; tr_item(a.w_in + (size_t)l * D * NIN + (size_t)(64 * kb) * NIN + 2056 + 32 * nb, NIN, (bf16*)(ws + WS_WIN + l * WIN_L) + (size_t)(2048 + 32 * nb) * D + 64 * kb, scr, lane); continue; }
        r -= IT_WINB;
        if (r < IT_WOUT) { const int kb = r / 32, nb = r % 32; tr_item(a.w_out + (size_t)l * D * D + (size_t)(64 * kb) * D + 32 * nb, D, (bf16*)(ws + WS_WOUT + l * WOUT_L) + (size_t)(32 * nb) * D + 64 * kb, scr, lane); continue; }
        r -= IT_WOUT;
        const int e = r / IT_EXP, q = r % IT_EXP, which = q / 512, qq = q % 512, kb = qq / 32, nb = qq % 32;
        const size_t so = ((size_t)(l * NE + e) * D + 64 * kb) * D + 32 * nb;
        if (which == 2) tr_item(a.w_down + so, D, (bf16*)(ws + WS_WD + l * WD_L + e * WD_E) + (size_t)(32 * nb) * D + 64 * kb, scr, lane);
        else { const int j0 = 32 * nb, row = 256 * (j0 >> 7) + (j0 & 127) + (which ? 128 : 0);
            tr_item((which ? a.w_up : a.w_gate) + so, D, (bf16*)(ws + WS_WGU + l * WGU_L + e * WGU_E) + (size_t)row * D + 64 * kb, scr, lane); }
    }
}
__device__ __forceinline__ void p0_mod(LAS unsigned char* lds, int item, int tid, int wave, int lane) {
    Args a; load_args(a);
    LAS float* cond = (LAS float*)(lds + RING_OFF);
    LAS float* red = (LAS float*)(lds + RING_OFF + 8192);
    for (int i = tid; i < 2 * D; i += NWAVES * 64) { const float cv = a.c[i]; cond[i] = cv / (1.f + expf(-cv)); }
    __syncthreads();
    const int l = item / 24, n0 = (item % 24) * 256;
    const float* w = a.w_mod + (size_t)l * D * NMODC + n0 + 4 * lane;
    f32x4 a0 = {0.f, 0.f, 0.f, 0.f}, a1 = {0.f, 0.f, 0.f, 0.f};
#pragma unroll 8
    for (int k = wave * 128; k < wave * 128 + 128; ++k) { const f32x4 wv = *(const f32x4*)(w + (size_t)k * NMODC); a0 += wv * cond[k]; a1 += wv * cond[D + k]; }
    *(LAS f32x4*)(red + (wave * 2 + 0) * 256 + 4 * lane) = a0; *(LAS f32x4*)(red + (wave * 2 + 1) * 256 + 4 * lane) = a1;
    __syncthreads();
    { const int b = tid >> 8, n = tid & 255; float s = 0.f;
#pragma unroll
        for (int wv = 0; wv < 8; ++wv) s += red[(wv * 2 + b) * 256 + n];
        ((float*)(a.ws + WS_MOD))[(size_t)(l * 2 + b) * NMODC + n0 + n] = s + a.b_mod[l * NMODC + n0 + n]; }
    __syncthreads();
}

__device__ __forceinline__ void prep_load(LAS float* vsc, LAS float* vsh, const Args& a, int l, int b, int tid) {
    const float* mo = (const float*)(a.ws + WS_MOD) + (size_t)(l * 2 + b) * NMODC;
    for (int i = tid; i < D; i += NWAVES * 64) { vsc[i] = mo[MO_SCA + i]; vsh[i] = mo[MO_SHA + i]; }
}
__device__ __forceinline__ void prep_wf(const Args& a, int l, LAS float* wfT, int tid) {
    for (int i = tid; i < 8 * D; i += NWAVES * 64) { const int k = i >> 3, h = i & 7; wfT[h * D + k] = a.w_in[(size_t)l * D * NIN + (size_t)k * NIN + 2048 + h]; }
}
__device__ __forceinline__ void prep_row(const LAS float* vsc, const LAS float* vsh, const LAS float* wfT, const f32x4 (&x)[4], int m, int rl, const float* __restrict__ bfor, bf16* __restrict__ UA, LAS float* lfs, int lane) {
    float dots[8];
#pragma unroll
    for (int h = 0; h < 8; ++h) dots[h] = 0.f;
    GAS unsigned long long* o8 = (GAS unsigned long long*)(UA + (size_t)m * D) + lane;
#pragma unroll
    for (int j = 0; j < 4; ++j) { const f32x4 u = x[j] * (1.f + *(const LAS f32x4*)(vsc + 256 * j + 4 * lane)) + *(const LAS f32x4*)(vsh + 256 * j + 4 * lane);
        o8[64 * j] = (unsigned long long)pk2(u[0], u[1]) | ((unsigned long long)pk2(u[2], u[3]) << 32);
#pragma unroll
        for (int h = 0; h < 8; ++h) { const f32x4 w = *(const LAS f32x4*)(wfT + h * D + 256 * j + 4 * lane); dots[h] += (u[0] * w[0] + u[1] * w[1]) + (u[2] * w[2] + u[3] * w[3]); }
        __builtin_amdgcn_sched_barrier(0); }
#pragma unroll
    for (int s = 0; s < 3; ++s) { const int half = 4 >> s; const unsigned long long mk = s == 0 ? 0xAAAAAAAAAAAAAAAAull : s == 1 ? 0xCCCCCCCCCCCCCCCCull : 0xF0F0F0F0F0F0F0F0ull;
#pragma unroll
        for (int i = 0; i < half; ++i) { const float keep = sel_m(dots[i], dots[half + i], mk), send = sel_m(dots[half + i], dots[i], mk); dots[i] = keep + __shfl_xor(send, 1 << s); } }
    float tot = dots[0];
    tot += __shfl_xor(tot, 8); tot += __shfl_xor(tot, 16); tot += __shfl_xor(tot, 32);
    if (lane < 8) { const int h = 4 * (lane & 1) + 2 * ((lane >> 1) & 1) + ((lane >> 2) & 1); lfs[rl * 8 + h] = log_sigmoid_f(tot + bfor[h]); }
}
__device__ __forceinline__ void prep_scan(const Args& a, LAS float* lfs, int m0, int wave, int lane) {
    if (wave == 0) {
        const int b = m0 / T, t0 = m0 % T; float* floc = (float*)(a.ws + WS_FLOC); float* ct = (float*)(a.ws + WS_CT);
#pragma unroll
        for (int h = 0; h < 8; ++h) { float v = lfs[lane * 8 + h];
#pragma unroll
            for (int o = 1; o < 64; o <<= 1) { const float t = __shfl_up(v, o); if (lane >= o) v += t; }
            floc[(size_t)(b * 8 + h) * T + t0 + lane] = v; if (lane == 63) ct[(b * 8 + h) * 128 + (t0 >> 6)] = v; }
    }
}
__device__ __forceinline__ void phase_prep0(LAS unsigned char* lds, int G, int tid, int wave, int lane) {
    Args a; load_args(a);
    LAS float* lfs = (LAS float*)(lds + RING_OFF); LAS float* wfT = (LAS float*)(lds + RING_OFF + 4096); LAS float* vsc = (LAS float*)(lds + RING_OFF + 36864); LAS float* vsh = vsc + D;
    prep_wf(a, 0, wfT, tid);
    for (int rb = blockIdx.x; rb < M / 64; rb += G) {
        const int m0 = rb * 64, b = m0 / T;
        prep_load(vsc, vsh, a, 0, b, tid);
        __syncthreads();
#pragma unroll 1
        for (int i = 0; i < 8; ++i) { const int rl = wave * 8 + i, m = m0 + rl; f32x4 x[4];
#pragma unroll
            for (int j = 0; j < 4; ++j) x[j] = *(const f32x4*)(a.x + (size_t)m * D + 256 * j + 4 * lane);
            prep_row(vsc, vsh, wfT, x, m, rl, a.b_forget, (bf16*)(a.ws + WS_UA), lfs, lane); }
        __syncthreads();
        prep_scan(a, lfs, m0, wave, lane);
        __syncthreads();
    }
}

__device__ __forceinline__ void phase_ln1_router(int l, LAS unsigned char* lds, int G, int tid_, int wave, int lane_) {
    int tid = tid_, lane = lane_; asm volatile("" : "+v"(tid), "+v"(lane));
    Args a; load_args(a); const float* __restrict__ Xin = (l == 0) ? a.x : a.out;
    LAS float* wrT = (LAS float*)(lds + RING_OFF);
    LAS float* lgs = (LAS float*)(lds + RING_OFF + 65536);
    LAS int* rinfo = (LAS int*)(lds + RING_OFF + 65536 + 4096);
    LAS float* rw = (LAS float*)(lds + RING_OFF + 65536 + 4096 + 1024);
    LAS int* lcnt = (LAS int*)(lds + RING_OFF + 65536 + 4096 + 2048);
    LAS float* vga = (LAS float*)(lds + RING_OFF + 65536 + 8192); LAS float* vscf = vga + D; LAS float* vshf = vscf + D; LAS float* vlg = vshf + D; LAS float* vlb = vlg + D;
    for (int i = tid; i < NE * D; i += NWAVES * 64) { const int k = i >> 4, e = i & 15; wrT[e * D + k] = a.w_router[i]; }
    unsigned char* ws = a.ws;
    const float* YB = (const float*)(ws + WS_YB); float* X1 = (float*)(ws + WS_X1); bf16* U2 = (bf16*)(ws + WS_U2);
    int* list = (int*)(ws + WS_LIST); int* toks = (int*)(ws + WS_TOKS); float* tokw = (float*)(ws + WS_TOKW);
    unsigned* cntg = (unsigned*)(ws + WS_CTL) + CW_CNT + l * 16 * 64;
    for (int rb = blockIdx.x; rb < M / 64; rb += G) {
        const int m0 = rb * 64, b = m0 / T;
        if (tid < 32) lcnt[tid] = 0;
        const float* mo = (const float*)(ws + WS_MOD) + (size_t)(l * 2 + b) * NMODC;
        for (int i = tid; i < D; i += NWAVES * 64) { vga[i] = 1.f + mo[MO_GA + i]; vscf[i] = 1.f + mo[MO_SCF + i]; vshf[i] = mo[MO_SHF + i]; vlg[i] = a.ln1_g[l * D + i]; vlb[i] = a.ln1_b[l * D + i]; }
        __syncthreads();
#pragma unroll 1
        for (int i = 0; i < 8; ++i) {
            const int rl = wave * 8 + i, m = m0 + rl; f32x4 v[4]; float s = 0.f;
#pragma unroll
            for (int j = 0; j < 4; ++j) { const size_t o = (size_t)m * D + 256 * j + 4 * lane; v[j] = ALPHA * *(const f32x4*)(Xin + o) + *(const LAS f32x4*)(vga + 256 * j + 4 * lane) * *(const f32x4*)(YB + o); s += (v[j][0] + v[j][1]) + (v[j][2] + v[j][3]); }
            const float mu = wave_sum(s) * (1.f / D); float q = 0.f;
#pragma unroll
            for (int j = 0; j < 4; ++j) { v[j] = v[j] - mu; q += (v[j][0] * v[j][0] + v[j][1] * v[j][1]) + (v[j][2] * v[j][2] + v[j][3] * v[j][3]); }
            const float rstd = 1.f / sqrtf(wave_sum(q) * (1.f / D) + LN_EPS);
            float lgt[16];
#pragma unroll
            for (int e = 0; e < 16; ++e) lgt[e] = 0.f;
            GAS unsigned long long* o8 = (GAS unsigned long long*)(U2 + (size_t)m * D) + lane;
#pragma unroll
            for (int j = 0; j < 4; ++j) { const int kk = 256 * j + 4 * lane; const f32x4 x1 = v[j] * rstd * *(const LAS f32x4*)(vlg + kk) + *(const LAS f32x4*)(vlb + kk); *(f32x4*)(X1 + (size_t)m * D + kk) = x1;
                const f32x4 u = x1 * *(const LAS f32x4*)(vscf + kk) + *(const LAS f32x4*)(vshf + kk);
                o8[64 * j] = (unsigned long long)pk2(u[0], u[1]) | ((unsigned long long)pk2(u[2], u[3]) << 32);
#pragma unroll
                for (int e = 0; e < 16; ++e) { const f32x4 w = *(const LAS f32x4*)(wrT + e * D + 256 * j + 4 * lane); lgt[e] += (u[0] * w[0] + u[1] * w[1]) + (u[2] * w[2] + u[3] * w[3]); if ((e & 3) == 3) __builtin_amdgcn_sched_barrier(0); } }
#pragma unroll
            for (int s2 = 0; s2 < 4; ++s2) { const int half = 8 >> s2; const unsigned long long mk = s2 == 0 ? 0xAAAAAAAAAAAAAAAAull : s2 == 1 ? 0xCCCCCCCCCCCCCCCCull : s2 == 2 ? 0xF0F0F0F0F0F0F0F0ull : 0xFF00FF00FF00FF00ull;
#pragma unroll
                for (int k = 0; k < half; ++k) { const float keep = sel_m(lgt[k], lgt[half + k], mk), send = sel_m(lgt[half + k], lgt[k], mk); lgt[k] = keep + __shfl_xor(send, 1 << s2); } }
            float tot = lgt[0]; tot += __shfl_xor(tot, 16); tot += __shfl_xor(tot, 32);
            if (lane < 16) { const int e = 8 * (lane & 1) + 4 * ((lane >> 1) & 1) + 2 * ((lane >> 2) & 1) + ((lane >> 3) & 1); lgs[rl * 16 + e] = tot; }
        }
        LDS_WAIT();
        if (lane < 8) {
            const int rl = wave * 8 + lane; const LAS float* L = lgs + rl * 16;
            float mx = L[0];
            for (int e = 1; e < 16; ++e) mx = fmaxf(mx, L[e]);
            float sum = 0.f;
            for (int e = 0; e < 16; ++e) sum += expf(L[e] - mx);
            const float inv = 1.f / sum;
            int bg = 0; float bgs = -INFINITY;
            for (int g = 0; g < 4; ++g) { float t1 = -INFINITY, t2 = -INFINITY;
                for (int k = 0; k < 4; ++k) { const float sv = expf(L[g * 4 + k] - mx) * inv + a.b_router[g * 4 + k]; if (sv > t1) { t2 = t1; t1 = sv; } else if (sv > t2) t2 = sv; }
                const float gs = t1 + t2; if (gs > bgs) { bgs = gs; bg = g; } }
            int i0 = 0, i1 = 0; float t1 = -INFINITY, t2 = -INFINITY, p0 = 0.f, p1 = 0.f;
            for (int k = 0; k < 4; ++k) { const int e = bg * 4 + k; const float pr = expf(L[e] - mx) * inv, sv = pr + a.b_router[e];
                if (sv > t1) { t2 = t1; i1 = i0; p1 = p0; t1 = sv; i0 = e; p0 = pr; } else if (sv > t2) { t2 = sv; i1 = e; p1 = pr; } }
            const int r0 = atomicAdd((int*)&lcnt[i0], 1), r1 = atomicAdd((int*)&lcnt[i1], 1);
            rinfo[rl * 4 + 0] = i0; rinfo[rl * 4 + 1] = i1; rinfo[rl * 4 + 2] = r0; rinfo[rl * 4 + 3] = r1;
            const float wsum = p0 + p1; rw[rl * 2] = p0 / wsum; rw[rl * 2 + 1] = p1 / wsum;
        }
        __syncthreads();
        if (tid < 16) { const int n = lcnt[tid]; lcnt[16 + tid] = n ? (int)__hip_atomic_fetch_add(cntg + tid * 64, (unsigned)n, RLX_AGENT) : 0; }
        __syncthreads();
        if (tid < 64) { const int m = m0 + tid, e0 = rinfo[tid * 4], e1 = rinfo[tid * 4 + 1], q0 = lcnt[16 + e0] + rinfo[tid * 4 + 2], q1 = lcnt[16 + e1] + rinfo[tid * 4 + 3];
            list[(size_t)e0 * M + q0] = m; list[(size_t)e1 * M + q1] = m; toks[m * 2] = (e0 << 16) | q0; toks[m * 2 + 1] = (e1 << 16) | q1; tokw[m * 2] = rw[tid * 2]; tokw[m * 2 + 1] = rw[tid * 2 + 1]; }
        __syncthreads();
    }
}

__device__ __forceinline__ void moe_tables(const Args& a, int l, LAS int* tab, int tid) {
    if (tid == 0) { unsigned* cntg = (unsigned*)(a.ws + WS_CTL) + CW_CNT + l * 16 * 64; int run = 0;
        for (int e = 0; e < NE; ++e) { const int n = (int)__hip_atomic_load(cntg + e * 64, RLX_AGENT); tab[e] = n; tab[16 + e] = run; const int nb = (n + 255) >> 8; for (int k = 0; k < nb; ++k) tab[64 + run + k] = e; run += nb; }
        tab[32] = run; tab[33] = run; }
    __syncthreads();
}
struct MoeSched {
    const pg8::bf16_t* A; const unsigned char* W; const int* list; const LAS int* tab; int NT, G, vcu, K; size_t wstride;
    __device__ __forceinline__ bool next(int i, pg8::Unit& u) const {
        const int L = i * G + vcu; if (L >= tab[33] * NT) return false;
        const int rb = L / NT; u.pm = rb; u.pn = L - rb * NT; u.e = tab[64 + rb]; u.r0 = (rb - tab[16 + u.e]) * 256; u.nv = tab[u.e] - u.r0; return true;
    }
    __device__ __forceinline__ const char* aptr(const pg8::Unit& u) const { return (const char*)A + (size_t)u.pm * (size_t)256 * K * 2; }
    __device__ __forceinline__ const char* bptr(const pg8::Unit& u) const { return (const char*)W + (size_t)u.e * wstride + (size_t)u.pn * (size_t)256 * K * 2; }
    __device__ __forceinline__ void arows4(const pg8::Unit& u, int r, int (&t)[4]) const {
        const GAS int* lp = (const GAS int*)list + (size_t)u.e * M + u.r0; const int last = u.nv - 1;
#pragma unroll
        for (int k = 0; k < 4; ++k) { const int rr = r + 64 * k; t[k] = lp[rr < last ? rr : last]; }
    }
};
struct MoeSchedG : MoeSched {
    __device__ __forceinline__ const char* aptr(const pg8::Unit&) const { return (const char*)A; }
};

__device__ __forceinline__ void phase_combine_ln2(int l, LAS unsigned char* lds, int G, int tid_, int wave, int lane_) {
    int tid = tid_, lane = lane_; asm volatile("" : "+v"(tid), "+v"(lane));
    Args a; load_args(a); float* __restrict__ Xout = a.out;
    LAS float* lfs = (LAS float*)(lds + RING_OFF); LAS float* wfT = (LAS float*)(lds + RING_OFF + 4096); LAS float* vsc = (LAS float*)(lds + RING_OFF + 36864); LAS float* vsh = vsc + D;
    LAS float* vgf = vsh + D; LAS float* vlg = vgf + D; LAS float* vlb = vlg + D;
    LAS int* tab = (LAS int*)(lds + LDSCTL_OFF);
    unsigned char* ws = a.ws;
    if (l + 1 < DEPTH) prep_wf(a, l + 1, wfT, tid);
    moe_tables(a, l, tab, tid);
    const float* X1 = (const float*)(ws + WS_X1); const bf16* YD = (const bf16*)(ws + WS_YD); const int* toks = (const int*)(ws + WS_TOKS); const float* tokw = (const float*)(ws + WS_TOKW);
    const bool nxt = (l + 1 < DEPTH);
    for (int rb = blockIdx.x; rb < M / 64; rb += G) {
        const int m0 = rb * 64, b = m0 / T;
        const float* mo = (const float*)(ws + WS_MOD) + (size_t)(l * 2 + b) * NMODC;
        __syncthreads();
        for (int i = tid; i < D; i += NWAVES * 64) { vgf[i] = 1.f + mo[MO_GF + i]; vlg[i] = a.ln2_g[l * D + i]; vlb[i] = a.ln2_b[l * D + i]; }
        if (nxt) prep_load(vsc, vsh, a, l + 1, b, tid);
        __syncthreads();
#pragma unroll 1
        for (int i = 0; i < 8; ++i) {
            const int rl = wave * 8 + i, m = m0 + rl;
            const int s0 = toks[m * 2], s1 = toks[m * 2 + 1]; const float w0 = tokw[m * 2], w1 = tokw[m * 2 + 1];
            const size_t r0 = (size_t)(tab[16 + (s0 >> 16)] * 256 + (s0 & 0xffff)), r1 = (size_t)(tab[16 + (s1 >> 16)] * 256 + (s1 & 0xffff));
            const GAS unsigned long long* y0 = (const GAS unsigned long long*)(YD + r0 * D) + lane; const GAS unsigned long long* y1 = (const GAS unsigned long long*)(YD + r1 * D) + lane;
            f32x4 v[4]; float s = 0.f;
#pragma unroll
            for (int j = 0; j < 4; ++j) { const unsigned long long p = y0[64 * j], q = y1[64 * j];
                const f32x4 ya = {bflo((unsigned)p), bfhi((unsigned)p), bflo((unsigned)(p >> 32)), bfhi((unsigned)(p >> 32))}, yb = {bflo((unsigned)q), bfhi((unsigned)q), bflo((unsigned)(q >> 32)), bfhi((unsigned)(q >> 32))};
                v[j] = ALPHA * *(const f32x4*)(X1 + (size_t)m * D + 256 * j + 4 * lane) + *(const LAS f32x4*)(vgf + 256 * j + 4 * lane) * (w0 * ya + w1 * yb); s += (v[j][0] + v[j][1]) + (v[j][2] + v[j][3]); }
            const float mu = wave_sum(s) * (1.f / D); float q = 0.f;
#pragma unroll
            for (int j = 0; j < 4; ++j) { v[j] = v[j] - mu; q += (v[j][0] * v[j][0] + v[j][1] * v[j][1]) + (v[j][2] * v[j][2] + v[j][3] * v[j][3]); }
            const float rstd = 1.f / sqrtf(wave_sum(q) * (1.f / D) + LN_EPS);
#pragma unroll
            for (int j = 0; j < 4; ++j) { v[j] = v[j] * rstd * *(const LAS f32x4*)(vlg + 256 * j + 4 * lane) + *(const LAS f32x4*)(vlb + 256 * j + 4 * lane); *(f32x4*)(Xout + (size_t)m * D + 256 * j + 4 * lane) = v[j]; }
            if (nxt) prep_row(vsc, vsh, wfT, v, m, rl, a.b_forget + (l + 1) * 8, (bf16*)(ws + WS_UA), lfs, lane);
        }
        if (nxt) { __syncthreads(); prep_scan(a, lfs, m0, wave, lane); __syncthreads(); }
    }
}

__global__ void __launch_bounds__(NWAVES * 64, 2) mk_fwd(Args args) {
    extern __shared__ __attribute__((aligned(16))) unsigned char lds_raw[];
    LAS unsigned char* lds = (LAS unsigned char*)lds_raw;
    volatile LAS unsigned* MISC = (volatile LAS unsigned*)(lds + MISC_OFF);
    const int tid = threadIdx.x, lane = tid & 63, wave = __builtin_amdgcn_readfirstlane(tid >> 6);
    const int G = gridDim.x; int vcu; { const int bx = blockIdx.x; vcu = (G % 8 == 0) ? (bx % 8) * (G / 8) + bx / 8 : bx; }
    for (int u = tid; u < (LDS_BYTES - LDSCTL_OFF) / 4; u += NWAVES * 64) ((LAS unsigned*)(lds + LDSCTL_OFF))[u] = 0u;
    __syncthreads();
    XcdBarrier bar; bar.bar = (unsigned*)(args.ws + WS_CTL) + CW_BAR; bar.x = 0; bar.st = nullptr;
    if (args.use_bar) bar = xcd_barrier_post((unsigned*)(args.ws + WS_CTL) + CW_BAR, MISC + 8);
    const int lo = args.ph_lo, hi = args.ph_hi;
#define IN(k) (lo <= (k) && (k) < hi)
#define SEAM(k) do { if (IN(k) && IN((k) + 1)) xcd_barrier(bar); } while (0)

    if (IN(0)) {
        for (int it = (int)blockIdx.x; it < DEPTH * 24; it += G) p0_mod(lds, it, tid, wave, lane);
        p0_weights(lds, vcu * NWAVES + wave, G * NWAVES, wave, lane);
    }
    SEAM(0);
    if (IN(1)) phase_prep0(lds, G, tid, wave, lane);
    SEAM(1);

#define MK_LAYER(l) { \
        const int pb = 2 + 7 * l; \
        if (IN(pb + 0)) { \
            Args A_; load_args(A_); unsigned char* ws = A_.ws; \
            pg8::DenseSched S; S.init((const pg8::bf16_t*)(ws + WS_UA), (const pg8::bf16_t*)(ws + WS_WIN + l * WIN_L), M, NPROJ, D, G, (int)blockIdx.x); \
            pg8::EpiBf16S E{(pg8::bf16_t*)(ws + WS_PQ), NPROJ, 0x303u, attn_body::C2}; \
            pg8::gemm_phase<pg8::EpiBf16S, pg8::DenseSched, true, false>(lds + RING_OFF, D, S, E); \
        } \
        SEAM(pb + 0); \
        if (IN(pb + 1)) { \
            Args A_; load_args(A_); unsigned char* ws = A_.ws; \
            const attn_body::bf16* PQ = (const attn_body::bf16*)(ws + WS_PQ); attn_body::bf16* OB = (attn_body::bf16*)(ws + WS_OB); \
            const float* gn = A_.out_norm_g + l * D; \
            for (int v = vcu; v < 256; v += G) { \
                const int bh = v >> 4, s = v & 15, b = bh >> 3, h = bh & 7; \
                const float* floc = (const float*)(ws + WS_FLOC) + (size_t)bh * T; const float* ct = (const float*)(ws + WS_CT) + bh * 128; \
                for (int k = 0; k < 2; ++k) { const int qb = k ? 31 - s : s; \
                    attn_body::fox_unit<8>(b, h, qb, PQ + PC_FQ, PQ + PC_FK, PQ + PC_FV, PQ + PC_FG, OB, floc, ct, gn, (char*)lds_raw + RING_OFF); } \
                for (int k = 0; k < 2; ++k) { const int qb = k ? 31 - s : s; \
                    attn_body::sb_wave(b, h, qb * 256 + wave * 32, PQ + PC_SQ, PQ + PC_SK, PQ + PC_SV, OB + 512, gn + 512, (char*)lds_raw + RING_OFF + wave * 16384, lane); } \
                __syncthreads(); \
            } \
        } \
        SEAM(pb + 1); \
        if (IN(pb + 2)) { \
            Args A_; load_args(A_); unsigned char* ws = A_.ws; \
            pg8::DenseSched S; S.init((const pg8::bf16_t*)(ws + WS_OB), (const pg8::bf16_t*)(ws + WS_WOUT + l * WOUT_L), M, D, D, G, (int)blockIdx.x); \
            pg8::EpiF32 E{(float*)(ws + WS_YB), D}; \
            pg8::gemm_phase<pg8::EpiF32, pg8::DenseSched, true, false>(lds + RING_OFF, D, S, E); \
        } \
        SEAM(pb + 2); \
        if (IN(pb + 3)) phase_ln1_router(l, lds, G, tid, wave, lane); \
        SEAM(pb + 3); \
        if (IN(pb + 4)) { \
            Args A_; load_args(A_); unsigned char* ws = A_.ws; \
            LAS int* tab = (LAS int*)(lds + LDSCTL_OFF); moe_tables(A_, l, tab, tid); \
            MoeSchedG S; S.A = (const pg8::bf16_t*)(ws + WS_U2); S.W = ws + WS_WGU + l * WGU_L; S.list = (const int*)(ws + WS_LIST); S.tab = tab; S.NT = 8; S.G = G; S.vcu = vcu; S.K = D; S.wstride = WGU_E; \
            pg8::EpiGateUp E{(pg8::bf16_t*)(ws + WS_HB), D}; \
            pg8::gemm_phase<pg8::EpiGateUp, MoeSchedG, true, true>(lds + RING_OFF, D, S, E); \
        } \
        SEAM(pb + 4); \
        if (IN(pb + 5)) { \
            Args A_; load_args(A_); unsigned char* ws = A_.ws; \
            LAS int* tab = (LAS int*)(lds + LDSCTL_OFF); moe_tables(A_, l, tab, tid); \
            MoeSched S; S.A = (const pg8::bf16_t*)(ws + WS_HB); S.W = ws + WS_WD + l * WD_L; S.list = nullptr; S.tab = tab; S.NT = 4; S.G = G; S.vcu = vcu; S.K = D; S.wstride = WD_E; \
            pg8::EpiBf16S E{(pg8::bf16_t*)(ws + WS_YD), D, 0u, 1.f}; \
            pg8::gemm_phase<pg8::EpiBf16S, MoeSched, true, false>(lds + RING_OFF, D, S, E); \
        } \
        SEAM(pb + 5); \
        if (IN(pb + 6)) phase_combine_ln2(l, lds, G, tid, wave, lane); \
        SEAM(pb + 6); \
    }
    MK_LAYER(0) MK_LAYER(1) MK_LAYER(2) MK_LAYER(3)
#undef MK_LAYER
#undef IN
#undef SEAM
}

static int g_grid = 0;
static bool mk_setup() {
    if (g_grid) return g_grid > 0;
    int dev = 0, cus = 0, per_cu = 0;
    if (hipGetDevice(&dev) != hipSuccess || hipDeviceGetAttribute(&cus, hipDeviceAttributeMultiprocessorCount, dev) != hipSuccess) { g_grid = -1; return false; }
    if (hipFuncSetAttribute((const void*)mk_fwd, hipFuncAttributeMaxDynamicSharedMemorySize, LDS_BYTES) != hipSuccess) { fprintf(stderr, "mk: hipFuncSetAttribute failed\n"); g_grid = -1; return false; }
    if (hipOccupancyMaxActiveBlocksPerMultiprocessor(&per_cu, (const void*)mk_fwd, NWAVES * 64, LDS_BYTES) != hipSuccess || per_cu < 1) fprintf(stderr, "mk: occupancy query reports %d\n", per_cu);
    (void)hipGetLastError();
    g_grid = cus;
    return true;
}
static void fill_args(Args& a, void* const* d_in, float* out, void* d_ws) {
    const float** f = (const float**)&a;
    for (int i = 0; i < 17; ++i) f[i] = (const float*)d_in[i];
    a.out = out; a.ws = (unsigned char*)d_ws; a.pad = 0;
}
static void launch_range(Args a, int lo, int hi, int use_bar, hipStream_t stream) {
    a.ph_lo = lo; a.ph_hi = hi; a.use_bar = use_bar;
    hipLaunchKernelGGL(mk_fwd, dim3(g_grid), dim3(NWAVES * 64), LDS_BYTES, stream, a);
}
}
extern "C" void kernel_launch(void* const* d_in, const int* in_sizes, int n_in, void* d_out, int out_size, void* d_ws, size_t ws_size, hipStream_t stream) {
    if (!mk::mk_setup()) return;
    if (ws_size < mk::WS_END) { fprintf(stderr, "ws too small\n"); return; }
    (void)hipMemsetAsync((char*)d_ws + mk::WS_CTL, 0, mk::CTL_ZERO_BYTES, stream);
    mk::Args a{}; mk::fill_args(a, d_in, (float*)d_out, d_ws);
    mk::launch_range(a, 0, mk::N_PHASES, 1, stream);
}
```

```cpp
#include <hip/hip_runtime.h>
#include <cstdio>
#include <cstdint>
#include <cmath>
namespace pg8 {
#define PG8_LAS __attribute__((address_space(3)))
typedef unsigned short bf16_t;
typedef short bf16x8 __attribute__((ext_vector_type(8)));
typedef float f32x4 __attribute__((ext_vector_type(4)));
typedef unsigned u32x4 __attribute__((ext_vector_type(4)));
constexpr int BM = 256, BK = 64, HALF = 128, HTB = HALF * BK * 2  , STAGE_BYTES = 8 * HTB, NXCD = 8, WGM = 8;

__host__ __device__ __forceinline__ int lds_byte(int r, int c) { const int st = (r >> 4) * 2 + (c >> 5), rr = r & 15, cc = c & 31, ob = rr * 64 + cc * 2; return st * 1024 + (ob ^ (((ob >> 9) & 1) << 5)); }
__host__ __device__ __forceinline__ void stage_rc(int b, int& R, int& C) { const int st = b / 1024, sb = b % 1024, swz = sb ^ (((sb >> 9) & 1) << 5); R = (st >> 1) * 16 + swz / 64; C = (st & 1) * 32 + (swz % 64) / 2; }
__host__ __device__ __forceinline__ int perm32(int rho) { const int n = rho >> 4, i = rho & 15; return 8 * (i >> 2) + 4 * n + (i & 3); }

struct Unit { int pm, pn, e, r0, nv; };

struct DenseSched {
    const bf16_t* A; const bf16_t* Bt; int K; int nM, nN, nwg, G, c;
    __device__ void init(const bf16_t* A_, const bf16_t* Bt_, int M, int N, int K_, int G_, int c_) { A = A_; Bt = Bt_; K = K_; nM = M / BM; nN = N / BM; nwg = nM * nN; G = G_; c = c_; }
    __device__ __forceinline__ bool next(int i, Unit& u) const {
        const long L = (long)i * G + c; if (L >= nwg) return false;
        int wgid = (int)L; { const int q = nwg / NXCD, r = nwg % NXCD, xcd = wgid % NXCD, off = wgid / NXCD; wgid = (xcd < r ? xcd * (q + 1) : r * (q + 1) + (xcd - r) * q) + off; }
        const int nig = WGM * nN, gid = wgid / nig, fm = gid * WGM, gsz = (nM - fm) < WGM ? (nM - fm) : WGM;
        u.pm = fm + ((wgid % nig) % gsz); u.pn = (wgid % nig) / gsz; u.e = 0; u.r0 = 0; u.nv = 256; return true;
    }
    __device__ __forceinline__ const char* aptr(const Unit& u) const { return (const char*)A + (size_t)u.pm * (size_t)(2 * HALF) * K * 2; }
    __device__ __forceinline__ const char* bptr(const Unit& u) const { return (const char*)Bt + (size_t)u.pn * (size_t)(2 * HALF) * K * 2; }
};

__device__ __forceinline__ unsigned cvt_pk_bf16(float lo, float hi) { unsigned r; asm volatile("v_cvt_pk_bf16_f32 %0, %1, %2" : "=v"(r) : "v"(lo), "v"(hi)); return r; }

struct EpiBf16S {
    static constexpr bool PERM = true;
    bf16_t* O; int ldc; unsigned qmask; float sc_q;
    __device__ __forceinline__ void operator()(const f32x4 (&acc)[2][2][4][2], const Unit& u, int wr, int wc, int fr, int fq) const {
        const int row0 = u.pm * BM + wr * 64 + fr, col0 = u.pn * BM + wc * 32 + 8 * fq;
        const float sc = ((qmask >> u.pn) & 1u) ? sc_q : 1.f;
#pragma unroll
        for (int ai = 0; ai < 2; ++ai)
#pragma unroll
            for (int m = 0; m < 4; ++m) { bf16_t* rowp = O + (size_t)(row0 + ai * HALF + m * 16) * ldc + col0;
#pragma unroll
                for (int bj = 0; bj < 2; ++bj) { const f32x4 v0 = acc[ai][bj][m][0] * sc, v1 = acc[ai][bj][m][1] * sc;
                    u32x4 w; w.x = cvt_pk_bf16(v0[0], v0[1]); w.y = cvt_pk_bf16(v0[2], v0[3]); w.z = cvt_pk_bf16(v1[0], v1[1]); w.w = cvt_pk_bf16(v1[2], v1[3]);
                    *(u32x4*)(rowp + bj * HALF) = w; } }
    }
};
struct EpiF32 {
    static constexpr bool PERM = false;
    float* O; int ldc;
    __device__ __forceinline__ void operator()(const f32x4 (&acc)[2][2][4][2], const Unit& u, int wr, int wc, int fr, int fq) const {
        const int row0 = u.pm * BM + wr * 64 + fr, col0 = u.pn * BM + wc * 32 + 4 * fq;
#pragma unroll
        for (int ai = 0; ai < 2; ++ai)
#pragma unroll
            for (int m = 0; m < 4; ++m) { float* rowp = O + (size_t)(row0 + ai * HALF + m * 16) * ldc + col0;
#pragma unroll
                for (int bj = 0; bj < 2; ++bj)
#pragma unroll
                    for (int n = 0; n < 2; ++n) *(f32x4*)(rowp + bj * HALF + n * 16) = acc[ai][bj][m][n]; }
    }
};
struct EpiGateUp {
    static constexpr bool PERM = true;
    bf16_t* O; int ldc;
    __device__ __forceinline__ void operator()(const f32x4 (&acc)[2][2][4][2], const Unit& u, int wr, int wc, int fr, int fq) const {
        const int row0 = u.pm * BM + wr * 64 + fr, col0 = u.pn * HALF + wc * 32 + 8 * fq;
#pragma unroll
        for (int ai = 0; ai < 2; ++ai)
#pragma unroll
            for (int m = 0; m < 4; ++m) { bf16_t* rowp = O + (size_t)(row0 + ai * HALF + m * 16) * ldc + col0;
                float h[8];
#pragma unroll
                for (int n = 0; n < 2; ++n)
#pragma unroll
                    for (int j = 0; j < 4; ++j) { const float g = acc[ai][0][m][n][j], up = acc[ai][1][m][n][j];
                        const float sg = __builtin_amdgcn_rcpf(1.f + __builtin_amdgcn_exp2f(-1.4426950408889634f * g)); h[n * 4 + j] = g * sg * up; }
                u32x4 w; w.x = cvt_pk_bf16(h[0], h[1]); w.y = cvt_pk_bf16(h[2], h[3]); w.z = cvt_pk_bf16(h[4], h[5]); w.w = cvt_pk_bf16(h[6], h[7]);
                *(u32x4*)rowp = w; }
    }
};

template <class Epi, class Sched, bool ALIGN_EPI, bool GATHER>
__device__ __forceinline__ void gemm_phase(PG8_LAS unsigned char* lds, const int K, const Sched& S, const Epi& E) {
    int tid_ = threadIdx.x; asm volatile("" : "+v"(tid_));
    const int tid = tid_, wid = __builtin_amdgcn_readfirstlane(tid >> 6), lane = tid & 63, wr = wid >> 2, wc = wid & 3, fr = lane & 15, fq = lane >> 4;
    const int nt = K / BK;
    unsigned voffB[2]; int RA0; unsigned CA2;
    { int R, C; stage_rc(tid * 16, R, C); RA0 = R; CA2 = (unsigned)C * 2u;
#pragma unroll
      for (int i = 0; i < 2; ++i) { const int Ri = R + 64 * i, Rb = Epi::PERM ? ((Ri & ~31) + perm32(Ri & 31)) : Ri; voffB[i] = (unsigned)(Rb * K + C) * 2u; } }
    const size_t kstep = (size_t)(BK * 2);
    const size_t hstep = (size_t)HALF * K * 2;
    const unsigned ldsw = (unsigned)wid * 1024u;
    const int aoff = lds_byte(wr * 64 + fr, fq * 8), boff = lds_byte(wc * 32 + fr, fq * 8);
#define PG8_SA(b, h) (((b) * 2 + (h)) * HTB)
#define PG8_SB(b, h) ((4 + (b) * 2 + (h)) * HTB)
#define PG8_STAGE(bufoff, gbase, voff) do { _Pragma("unroll") for (int _i = 0; _i < 2; ++_i) \
        __builtin_amdgcn_global_load_lds((const unsigned*)((const char*)(gbase) + (voff)[_i]), (PG8_LAS unsigned*)(lds + (bufoff) + ldsw + _i * 8192), 16, 0, 0); } while (0)
#define PG8_LDA(dst, b, h) do { _Pragma("unroll") for (int m = 0; m < 4; ++m) _Pragma("unroll") for (int k = 0; k < 2; ++k) dst[m][k] = *(const PG8_LAS bf16x8*)(lds + PG8_SA(b, h) + aoff + m * 2048 + k * 1024); } while (0)
#define PG8_LDB(dst, b, h) do { _Pragma("unroll") for (int n = 0; n < 2; ++n) _Pragma("unroll") for (int k = 0; k < 2; ++k) dst[n][k] = *(const PG8_LAS bf16x8*)(lds + PG8_SB(b, h) + boff + n * 2048 + k * 1024); } while (0)
#define PG8_MMA(ai, bj, At, Bt) do { __builtin_amdgcn_s_setprio(1); _Pragma("unroll") for (int m = 0; m < 4; ++m) _Pragma("unroll") for (int n = 0; n < 2; ++n) _Pragma("unroll") for (int k = 0; k < 2; ++k) \
        acc[ai][bj][m][n] = __builtin_amdgcn_mfma_f32_16x16x32_bf16(Bt[n][k], At[m][k], acc[ai][bj][m][n], 0, 0, 0); __builtin_amdgcn_s_setprio(0); } while (0)
#define PG8_WAIT_V(n) asm volatile("s_waitcnt vmcnt(" #n ")" ::: "memory")
#define PG8_WAIT_L(n) asm volatile("s_waitcnt lgkmcnt(" #n ")" ::: "memory")
#define PG8_BAR __builtin_amdgcn_s_barrier()
#define PG8_SCHED __builtin_amdgcn_sched_barrier(0)
    Unit cur, nxt; int ui = 0;
    if (!S.next(0, cur)) return;
    f32x4 acc[2][2][4][2];
    float zf = 0.f; asm volatile("" : "+v"(zf));
#pragma unroll
    for (int a = 0; a < 2; ++a)
#pragma unroll
        for (int b = 0; b < 2; ++b)
#pragma unroll
            for (int m = 0; m < 4; ++m)
#pragma unroll
                for (int n = 0; n < 2; ++n) acc[a][b][m][n] = (f32x4){zf, zf, zf, zf};
    bf16x8 At[4][2], B0[2][2], B1[2][2];
    unsigned oc[2][2], on[2][2];
#define PG8_AOFF(dst, u) do { if constexpr (GATHER) { int _t[4]; S.arows4(u, RA0, _t); \
            _Pragma("unroll") for (int _k = 0; _k < 4; ++_k) dst[_k >> 1][_k & 1] = (unsigned)_t[_k] * (unsigned)(K * 2) + CA2; } \
        else { _Pragma("unroll") for (int _k = 0; _k < 4; ++_k) dst[_k >> 1][_k & 1] = (unsigned)((RA0 + 64 * _k) * K) * 2u + CA2; } } while (0)
    PG8_AOFF(oc, cur);
    const char* cA = S.aptr(cur); const char* cB = S.bptr(cur);
    PG8_STAGE(PG8_SB(0, 0), cB, voffB); PG8_STAGE(PG8_SB(0, 1), cB + hstep, voffB); PG8_STAGE(PG8_SA(0, 0), cA, oc[0]); PG8_STAGE(PG8_SA(0, 1), cA, oc[1]);
    if (wr == 1) PG8_BAR;
    PG8_WAIT_V(2); PG8_BAR;
    PG8_STAGE(PG8_SB(1, 0), cB + kstep, voffB); PG8_STAGE(PG8_SA(1, 0), cA + kstep, oc[0]); PG8_STAGE(PG8_SB(1, 1), cB + hstep + kstep, voffB);
    PG8_WAIT_V(6); PG8_BAR;
    for (;;) {
        const bool has_next = S.next(ui + 1, nxt);
        const char* nA = has_next ? S.aptr(nxt) : cA; const char* nB = has_next ? S.bptr(nxt) : cB;
        if (has_next) { PG8_AOFF(on, nxt); } else {
#pragma unroll
            for (int _h = 0; _h < 2; ++_h)
#pragma unroll
                for (int _i = 0; _i < 2; ++_i) on[_h][_i] = oc[_h][_i]; }
        for (int t = 0; t < nt; t += 2) {
            const bool last = (t == nt - 2);
            const char* a1 = cA + (size_t)(t + 1) * kstep;
            const char* a2 = last ? nA : cA + (size_t)(t + 2) * kstep; const char* b2 = last ? nB : cB + (size_t)(t + 2) * kstep;
            const char* a3 = a2 + kstep; const char* b3 = b2 + kstep;
            unsigned o2[2][2];
#pragma unroll
            for (int _h = 0; _h < 2; ++_h)
#pragma unroll
                for (int _i = 0; _i < 2; ++_i) o2[_h][_i] = last ? on[_h][_i] : oc[_h][_i];
            PG8_LDB(B0, 0, 0); PG8_LDB(B1, 0, 1); PG8_SCHED; PG8_LDA(At, 0, 0); PG8_STAGE(PG8_SA(1, 1), a1, oc[1]);
            PG8_WAIT_V(8); PG8_WAIT_L(0); PG8_BAR; PG8_MMA(0, 0, At, B0); PG8_MMA(0, 1, At, B1); PG8_BAR; PG8_SCHED;
            PG8_LDA(At, 0, 1); PG8_STAGE(PG8_SB(0, 0), b2, voffB); PG8_STAGE(PG8_SB(0, 1), b2 + hstep, voffB); PG8_STAGE(PG8_SA(0, 0), a2, o2[0]);
            PG8_WAIT_V(8); PG8_WAIT_L(0); PG8_BAR; PG8_MMA(1, 0, At, B0); PG8_MMA(1, 1, At, B1); PG8_BAR; PG8_SCHED;
            PG8_LDB(B0, 1, 0); PG8_LDB(B1, 1, 1); PG8_SCHED; PG8_LDA(At, 1, 0); PG8_STAGE(PG8_SA(0, 1), a2, o2[1]);
            PG8_WAIT_V(8); PG8_WAIT_L(0); PG8_BAR; PG8_MMA(0, 0, At, B0); PG8_MMA(0, 1, At, B1); PG8_BAR; PG8_SCHED;
            PG8_LDA(At, 1, 1); PG8_STAGE(PG8_SB(1, 0), b3, voffB); PG8_STAGE(PG8_SB(1, 1), b3 + hstep, voffB); PG8_STAGE(PG8_SA(1, 0), a3, o2[0]);
            PG8_WAIT_V(8); PG8_WAIT_L(0); PG8_BAR; PG8_MMA(1, 0, At, B0); PG8_MMA(1, 1, At, B1); PG8_BAR; PG8_SCHED;
        }
        if constexpr (ALIGN_EPI) { if (wr == 0) PG8_BAR; }
        E(acc, cur, wr, wc, fr, fq);
        if (!has_next) break;
#pragma unroll
        for (int a = 0; a < 2; ++a)
#pragma unroll
            for (int b = 0; b < 2; ++b)
#pragma unroll
                for (int m = 0; m < 4; ++m)
#pragma unroll
                    for (int n = 0; n < 2; ++n) acc[a][b][m][n] = (f32x4){zf, zf, zf, zf};
        cur = nxt; cA = nA; cB = nB; ++ui;
#pragma unroll
        for (int _h = 0; _h < 2; ++_h)
#pragma unroll
            for (int _i = 0; _i < 2; ++_i) oc[_h][_i] = on[_h][_i];
        if constexpr (ALIGN_EPI) { if (wr == 1) PG8_BAR; }
    }
    PG8_WAIT_V(0);
    if constexpr (!ALIGN_EPI) { if (wr == 0) PG8_BAR; }
    PG8_BAR;
#undef PG8_AOFF
#undef PG8_SA
#undef PG8_SB
#undef PG8_STAGE
#undef PG8_LDA
#undef PG8_LDB
#undef PG8_MMA
#undef PG8_WAIT_V
#undef PG8_WAIT_L
#undef PG8_BAR
#undef PG8_SCHED
}
}
#include <hip/hip_bf16.h>
namespace attn_body {
using bf16=__hip_bfloat16;
using bf16x8=__attribute__((ext_vector_type(8)))short;
using s16x4=__attribute__((ext_vector_type(4)))short;
using f32x16=__attribute__((ext_vector_type(16)))float;
using f32x4a=__attribute__((ext_vector_type(4)))float;
using u32x4=__attribute__((ext_vector_type(4)))unsigned;
constexpr int SEQ=8192,D=64,DM=3584,OD=1024;
constexpr int NW=8,QBLK=32,QB=QBLK*NW,KVBLK=64,NQB=SEQ/QB;
__device__ __forceinline__ int crow(int r,int hi){return (r&3)+8*(r>>2)+4*hi;}
#define SBAR() __builtin_amdgcn_sched_barrier(0)
__device__ __forceinline__ void cmask(f32x16&p0,f32x16&p1,int jb,int qrel,int hi){
  const float NEG=-INFINITY; int kb=64*jb+4*hi;
  #pragma unroll
  for(int r=0;r<16;++r){int kv=kb+(r&3)+8*(r>>2); if(kv>qrel)p0[r]=NEG; if(kv+32>qrel)p1[r]=NEG;}
}
constexpr int NSLOT=3, SLOTB=8192;
constexpr int LDS_K=0, LDS_V=NSLOT*SLOTB, LDS_WS=2*NSLOT*SLOTB, LDS_OST=LDS_WS+NW*64*4, LDS_TAB=LDS_OST+NW*4096, LDS_CT=LDS_TAB+SEQ*4, LDS_BYTES=LDS_CT+1024;
constexpr float LOG2E=1.4426950408889634f;
constexpr float C2=0.125f*LOG2E;
__device__ __forceinline__ void glds16(const void*gsrc,unsigned lds_dst){unsigned keep;
  asm volatile("s_mov_b32 %0, m0\n\ts_mov_b32 m0, %2\n\ts_nop 0\n\tglobal_load_lds_dwordx4 %1, off\n\ts_mov_b32 m0, %0":"=&s"(keep):"v"(gsrc),"s"(lds_dst):"memory");}
__device__ __forceinline__ float max3f(float a,float b,float c){float r;asm("v_max3_f32 %0, %1, %2, %3":"=v"(r):"v"(a),"v"(b),"v"(c));return r;}
__device__ __forceinline__ float max2f(float a,float b){float r;asm("v_max_f32_e32 %0, %1, %2":"=v"(r):"v"(a),"v"(b));return r;}
__device__ __forceinline__ float fadd_s(float a,float b){float r;asm("v_add_f32_e32 %0, %1, %2":"=v"(r):"v"(a),"v"(b));return r;}
__device__ __forceinline__ float fsub_s(float a,float b){float r;asm("v_sub_f32_e32 %0, %1, %2":"=v"(r):"v"(a),"v"(b));return r;}
typedef float f32x2_t __attribute__((ext_vector_type(2))); typedef __bf16 bf16x2_t __attribute__((ext_vector_type(2)));
__device__ __forceinline__ unsigned cvtpk_s(float lo,float hi){f32x2_t v={lo,hi};bf16x2_t b=__builtin_convertvector(v,bf16x2_t);return __builtin_bit_cast(unsigned,b);}
__device__ __forceinline__ float bf_lo(unsigned w){return __uint_as_float(w<<16);} __device__ __forceinline__ float bf_hi(unsigned w){return __uint_as_float(w&0xffff0000u);}
#define WAIT_BAR(N) asm volatile("s_waitcnt vmcnt(" #N ") lgkmcnt(0)\n\ts_barrier":::"memory")

__device__ __forceinline__ void qkt(f32x16&p0,f32x16&p1,const char*Kslot,const bf16x8*qr,const f32x16&negm,int r32,int hi){
  const char*kb=Kslot+hi*1024+r32*16;
  #pragma unroll
  for(int d0=0;d0<4;++d0){
    const bf16x8 b0=*reinterpret_cast<const bf16x8*>(kb+d0*2048);
    const bf16x8 b1=*reinterpret_cast<const bf16x8*>(kb+d0*2048+512);
    if(d0==0){p0=__builtin_amdgcn_mfma_f32_32x32x16_bf16(b0,qr[0],negm,0,0,0);p1=__builtin_amdgcn_mfma_f32_32x32x16_bf16(b1,qr[0],negm,0,0,0);}
    else{p0=__builtin_amdgcn_mfma_f32_32x32x16_bf16(b0,qr[d0],p0,0,0,0);p1=__builtin_amdgcn_mfma_f32_32x32x16_bf16(b1,qr[d0],p1,0,0,0);}}
}
typedef __attribute__((address_space(3))) const char* lds_cptr;
typedef short v4i16_t __attribute__((ext_vector_type(4)));
__device__ __forceinline__ void kload8(bf16x8*kf,lds_cptr kp){
  kf[0]=*(const __attribute__((address_space(3))) bf16x8*)(kp);      kf[1]=*(const __attribute__((address_space(3))) bf16x8*)(kp+512);
  kf[2]=*(const __attribute__((address_space(3))) bf16x8*)(kp+2048); kf[3]=*(const __attribute__((address_space(3))) bf16x8*)(kp+2560);
  kf[4]=*(const __attribute__((address_space(3))) bf16x8*)(kp+4096); kf[5]=*(const __attribute__((address_space(3))) bf16x8*)(kp+4608);
  kf[6]=*(const __attribute__((address_space(3))) bf16x8*)(kp+6144); kf[7]=*(const __attribute__((address_space(3))) bf16x8*)(kp+6656);
}
__device__ __forceinline__ void kload2(bf16x8*kf,lds_cptr kp,int j){ kf[2*j]=*(const __attribute__((address_space(3))) bf16x8*)(kp+j*2048); kf[2*j+1]=*(const __attribute__((address_space(3))) bf16x8*)(kp+j*2048+512); }
__device__ __forceinline__ s16x4 vtr(lds_cptr p){ return __builtin_bit_cast(s16x4,__builtin_amdgcn_ds_read_tr16_b64_v4i16((__attribute__((address_space(3))) v4i16_t*)p)); }
__device__ __forceinline__ float rowmax(const f32x16&p0,const f32x16&p1){
  float a=max3f(p0[0],p0[1],p1[0]),b=max3f(p0[2],p0[3],p1[1]);a=max3f(a,p1[2],p1[3]);
  #pragma unroll
  for(int r=4;r<16;r+=4){a=max3f(a,p0[r],p0[r+1]);b=max3f(b,p0[r+2],p0[r+3]);a=max3f(a,p1[r],p1[r+1]);b=max3f(b,p1[r+2],p1[r+3]);}
  const float m=max2f(a,b);
  auto rr=__builtin_amdgcn_permlane32_swap(__float_as_uint(m),__float_as_uint(m),false,false);
  return max2f(__uint_as_float(rr[0]),__uint_as_float(rr[1]));
}
__device__ __forceinline__ void pv(f32x16*o,int vb,bf16x8 pa0,bf16x8 pa1,bf16x8 pa2,bf16x8 pa3){
  #pragma unroll
  for(int d0=0;d0<2;++d0){s16x4 lo[4],hi[4];
    #pragma unroll
    for(int ks=0;ks<4;++ks){
      asm volatile("ds_read_b64_tr_b16 %0,%1 offset:%c2":"=&v"(lo[ks]):"v"(vb),"i"(d0*4096+ks*1024):"memory");
      asm volatile("ds_read_b64_tr_b16 %0,%1 offset:%c2":"=&v"(hi[ks]):"v"(vb),"i"(d0*4096+ks*1024+512):"memory");}
    asm volatile("s_waitcnt lgkmcnt(0)":::"memory");SBAR();
    #define PK(k) (bf16x8){lo[k][0],lo[k][1],lo[k][2],lo[k][3],hi[k][0],hi[k][1],hi[k][2],hi[k][3]}
    o[d0]=__builtin_amdgcn_mfma_f32_32x32x16_bf16(pa0,PK(0),o[d0],0,0,0);
    o[d0]=__builtin_amdgcn_mfma_f32_32x32x16_bf16(pa1,PK(1),o[d0],0,0,0);
    o[d0]=__builtin_amdgcn_mfma_f32_32x32x16_bf16(pa2,PK(2),o[d0],0,0,0);
    o[d0]=__builtin_amdgcn_mfma_f32_32x32x16_bf16(pa3,PK(3),o[d0],0,0,0);
    #undef PK
  }
}
__device__ __forceinline__ void head_norm_store(const bf16*stg,bf16*Ow,const bf16*gate,const float*g,int lane){
  const int ch=lane&7;
  const f32x4a g0=*(const f32x4a*)(g+ch*8), g1=*(const f32x4a*)(g+ch*8+4);
  #pragma unroll
  for(int i=0;i<4;++i){const int row=i*8+(lane>>3);
    const u32x4 v=*(const u32x4*)(stg+row*64+ch*8);
    float x[8]={bf_lo(v[0]),bf_hi(v[0]),bf_lo(v[1]),bf_hi(v[1]),bf_lo(v[2]),bf_hi(v[2]),bf_lo(v[3]),bf_hi(v[3])};
    float ss=0.f;
    #pragma unroll
    for(int j=0;j<8;++j)ss+=x[j]*x[j];
    ss+=__shfl_xor(ss,1);ss+=__shfl_xor(ss,2);ss+=__shfl_xor(ss,4);
    const float rs=1.0f/sqrtf(ss*(1.0f/64.0f)+1e-6f);
    float gm[8]={g0[0],g0[1],g0[2],g0[3],g1[0],g1[1],g1[2],g1[3]};
    if(gate){const u32x4 gv=*(const u32x4*)(gate+(long)row*DM+ch*8);
      float t[8]={bf_lo(gv[0]),bf_hi(gv[0]),bf_lo(gv[1]),bf_hi(gv[1]),bf_lo(gv[2]),bf_hi(gv[2]),bf_lo(gv[3]),bf_hi(gv[3])};
      #pragma unroll
      for(int j=0;j<8;++j)gm[j]*=__builtin_amdgcn_rcpf(1.0f+__builtin_amdgcn_exp2f(-LOG2E*t[j]));}
    u32x4 w;
    w[0]=cvtpk_s(x[0]*rs*gm[0],x[1]*rs*gm[1]);w[1]=cvtpk_s(x[2]*rs*gm[2],x[3]*rs*gm[3]);w[2]=cvtpk_s(x[4]*rs*gm[4],x[5]*rs*gm[5]);w[3]=cvtpk_s(x[6]*rs*gm[6],x[7]*rs*gm[7]);
    *(u32x4*)(Ow+(long)row*OD+ch*8)=w;}
}

template<int THRL,int VAR=0> __device__ __forceinline__ void fox_unit(int b,int h,int qb,const bf16*Q,const bf16*__restrict__ K,const bf16*__restrict__ V,const bf16*__restrict__ G,bf16*O,
                                                            const float*__restrict__ floc,const float*__restrict__ ct,const float*__restrict__ gn,char*shm){
  int tid_=threadIdx.x; asm volatile("":"+v"(tid_));
  const int tid=tid_,lane=tid&63,r32=lane&31,hi=lane>>5; const int wid=__builtin_amdgcn_readfirstlane(tid>>6);
  const long rowbase=(long)b*SEQ; const int q0=qb*QB;
  const bf16*Qw=Q+(rowbase+q0+wid*QBLK)*DM+h*D;
  const bf16*Kh=K+rowbase*DM+h*D,*Vh=V+rowbase*DM+h*D;
  const unsigned lds0=(unsigned)(uintptr_t)shm;
  float*wsf=(float*)(shm+LDS_WS)+wid*64;
  const bf16*ksrc=Kh+(long)lane*DM+wid*8;
  const bf16*vsrc=Vh+(long)(16*(wid&3)+(lane>>2))*DM+(wid>>2)*32+(lane&3)*8;
  const unsigned kdst=lds0+LDS_K+wid*1024, vdst=lds0+LDS_V+wid*1024;
  #define DMA_K(t,slot) glds16(ksrc+(long)(t)*KVBLK*DM,(unsigned)__builtin_amdgcn_readfirstlane(kdst+(slot)))
  #define DMA_V(t,slot) glds16(vsrc+(long)(t)*KVBLK*DM,(unsigned)__builtin_amdgcn_readfirstlane(vdst+(slot)))
  const int vb0=(int)(lds0+LDS_V)+((lane>>4)&1)*32+(lane&3)*8+(4*hi+((lane&15)>>2))*64;
  const char*Kbase=shm+LDS_K; bf16x8 kf[8];
  const lds_cptr shm3=(lds_cptr)shm; const lds_cptr kp0=shm3+LDS_K+hi*1024+r32*16; const lds_cptr vp0=shm3+LDS_V+((lane>>4)&1)*32+(lane&3)*8+(4*hi+((lane&15)>>2))*64;
  const int NT=(q0+QB)/KVBLK;
  DMA_K(0,0);DMA_V(0,0);DMA_K(1,SLOTB);
  float*cts=(float*)(shm+LDS_CT); float*offs=cts+128; float*tab=(float*)(shm+LDS_TAB);
  if constexpr(!(VAR&2)){
  if(tid<128)cts[tid]=ct[tid];
  __syncthreads();
  if(tid<128){const int c=tid,c0=4*qb; float a=0.f; if(c<c0){for(int k=c;k<c0;++k)a-=cts[k];}else{for(int k=c0;k<c;++k)a+=cts[k];} offs[c]=a;}
  __syncthreads();
  for(int s=tid;s<q0+QB;s+=512)tab[s]=-(offs[s>>6]+floc[s])*LOG2E;
  }
  const float ft2=(VAR&2)?0.f:(offs[(q0+wid*QBLK+r32)>>6]+floc[q0+wid*QBLK+r32])*LOG2E;
  __syncthreads();
  const __attribute__((address_space(3))) float*tab3=(const __attribute__((address_space(3))) float*)(shm3+LDS_TAB)+r32;
  float qa=hi?ft2:1.f;
  #define KA(dst,t,half) do{ if constexpr(VAR&1){dst=0.f;}else{ const float e_=tab3[(t)*64+(half)*32]; dst=hi?1.f:e_; } }while(0)
  #define BIASMF(C,ka) ((VAR&1)?C:__builtin_amdgcn_mfma_f32_32x32x2f32(ka,qa,C,0,0,0))
  bf16x8 qr[4];
  #pragma unroll
  for(int d0=0;d0<4;++d0)qr[d0]=*reinterpret_cast<const bf16x8*>(&Qw[(long)r32*DM+d0*16+hi*8]);
  float mhat=0.f,l_reg=0.f;f32x16 o[2];o[0]=f32x16{};o[1]=f32x16{};const f32x16 zero16=f32x16{};
  const int qrel=wid*QBLK+r32;
  #define CMASK(P0,P1,t) do{int jb_=(t)-(NT-4); if(jb_>=0)cmask(P0,P1,jb_,qrel,hi);}while(0)
  bool resc=false;
  #define START(P0,P1) do{ const float rm=rowmax(P0,P1); resc=false; \
    { const float dl=rm; mhat=fadd_s(mhat,dl); \
      _Pragma("unroll") for(int r=0;r<16;++r){P0[r]=fsub_s(P0[r],dl);P1[r]=fsub_s(P1[r],dl);} \
      qa=hi?(ft2-mhat):1.f; } \
    _Pragma("unroll") for(int r=0;r<16;++r)P0[r]=__builtin_amdgcn_exp2f(P0[r]); }while(0)
  #define RESC() do{ if(resc){ asm volatile("s_waitcnt lgkmcnt(0)":::"memory"); \
      _Pragma("unroll") for(int d_=0;d_<2;++d_) _Pragma("unroll") for(int r=0;r<16;++r)o[d_][r]*=wsf[crow(r,hi)]; } }while(0)
  f32x16 pA0,pA1,pB0,pB1;
  int sl_prev=0,sl_cur=0,sl_next=SLOTB;
  #define ROT() do{sl_prev=sl_cur;sl_cur=sl_next;sl_next=(sl_next==(NSLOT-1)*SLOTB)?0:sl_next+SLOTB;}while(0)
  DMA_K(2,2*SLOTB);
  WAIT_BAR(3);
  { float ka0,ka1; KA(ka0,0,0); KA(ka1,0,1);
    qkt(pA0,pA1,Kbase,qr,zero16,r32,hi);
    pA0=BIASMF(pA0,ka0); pA1=BIASMF(pA1,ka1); }
  asm volatile("s_nop 15\n\ts_nop 7":"+v"(pA0),"+v"(pA1));CMASK(pA0,pA1,0);
  START(pA0,pA1);
  _Pragma("unroll") for(int r=0;r<16;++r)pA1[r]=__builtin_amdgcn_exp2f(pA1[r]);
  WAIT_BAR(0);
  DMA_K(3,0);DMA_V(1,SLOTB);
  ROT();
  kload8(kf,kp0+sl_cur);
  WAIT_BAR(2);
  s16x4 vlo[8],vhi[8]; u32x4 pw0,pw1,pw2,pw3;
  #define PKW(P,B) cvtpk_s(P[B],P[B+1])
  #define PAF(k) __builtin_bit_cast(bf16x8,pw##k)
  #define VFR(i) (bf16x8){vlo[i][0],vlo[i][1],vlo[i][2],vlo[i][3],vhi[i][0],vhi[i][1],vhi[i][2],vhi[i][3]}
  #define PIN(x) asm volatile("":"+v"(x))
  #define MX3(a,b,c) __builtin_fmaxf(__builtin_fmaxf((a),(b)),(c))
  #define GAPA(MF,A0,A1,A2,A3,W0,W1,PW) do{ MF; sacc+=A0; sacc+=A1; sacc+=A2; sacc+=A3; PIN(sacc); W0; W1; PIN(PW); SBAR(); }while(0)
  #define EX(v) __builtin_amdgcn_exp2f(v)
  #define GAPB(MF,X,B) do{ MF; X[B]=EX(X[B]); X[B+1]=EX(X[B+1]); X[B+2]=EX(X[B+2]); X[B+3]=EX(X[B+3]); PIN(X); SBAR(); }while(0)
  #define VRD(i) do{ vlo[i]=vtr(vp_+(((i)>>2)*4096+((i)&3)*1024)); vhi[i]=vtr(vp_+(((i)>>2)*4096+((i)&3)*1024+512)); }while(0)
  #define KRD(G,j) do{ if(G){ kload2(kf,kp0+sl_next,j); SBAR(); } }while(0)
  #define STEP(C0,C1,P0,P1,t,GK,GV,GL) do{ SBAR(); \
    const lds_cptr vp_=vp0+sl_prev; float ka0_,ka1_; KA(ka0_,t,0); KA(ka1_,t,1); \
    VRD(0); SBAR(); float sacc=(P0[0]+P0[1]); \
    GAPA(C0=__builtin_amdgcn_mfma_f32_32x32x16_bf16(kf[0],qr[0],zero16,0,0,0), P0[2],P0[3],P0[4],P0[5],     pw0[0]=PKW(P0,0), pw0[1]=PKW(P0,2), pw0); \
    VRD(4); SBAR(); GAPA(C1=__builtin_amdgcn_mfma_f32_32x32x16_bf16(kf[1],qr[0],zero16,0,0,0), P0[6],P0[7],P0[8],P0[9],     pw0[2]=PKW(P0,4), pw0[3]=PKW(P0,6), pw0); \
    VRD(1); SBAR(); GAPA(C0=__builtin_amdgcn_mfma_f32_32x32x16_bf16(kf[2],qr[1],C0,0,0,0),   P0[10],P0[11],P0[12],P0[13], pw1[0]=PKW(P0,8), pw1[1]=PKW(P0,10), pw1); \
    VRD(5); SBAR(); GAPA(C1=__builtin_amdgcn_mfma_f32_32x32x16_bf16(kf[3],qr[1],C1,0,0,0),   P0[14],P0[15],P1[0],P1[1],   pw1[2]=PKW(P0,12),pw1[3]=PKW(P0,14), pw1); \
    VRD(2); SBAR(); GAPA(C0=__builtin_amdgcn_mfma_f32_32x32x16_bf16(kf[4],qr[2],C0,0,0,0),   P1[2],P1[3],P1[4],P1[5],     pw2[0]=PKW(P1,0), pw2[1]=PKW(P1,2), pw2); \
    VRD(6); SBAR(); GAPA(C1=__builtin_amdgcn_mfma_f32_32x32x16_bf16(kf[5],qr[2],C1,0,0,0),   P1[6],P1[7],P1[8],P1[9],     pw2[2]=PKW(P1,4), pw2[3]=PKW(P1,6), pw2); \
    VRD(3); SBAR(); GAPA(C0=__builtin_amdgcn_mfma_f32_32x32x16_bf16(kf[6],qr[3],C0,0,0,0),   P1[10],P1[11],P1[12],P1[13], pw3[0]=PKW(P1,8), pw3[1]=PKW(P1,10), pw3); \
    VRD(7); SBAR(); GAPA(C1=__builtin_amdgcn_mfma_f32_32x32x16_bf16(kf[7],qr[3],C1,0,0,0),   P1[14],P1[15],0.f,0.f,       pw3[2]=PKW(P1,12),pw3[3]=PKW(P1,14), pw3); \
    C0=BIASMF(C0,ka0_); C1=BIASMF(C1,ka1_); SBAR(); \
    l_reg+=sacc; \
    if(GK){DMA_K((t)+3,sl_cur);} if(GV){DMA_V((t)+1,sl_next);} \
    CMASK(C0,C1,t); \
    { float a=MX3(C0[0],C0[1],C1[0]),b=MX3(C0[2],C0[3],C1[1]); a=MX3(a,C1[2],C1[3]); \
      _Pragma("unroll") for(int r=4;r<16;r+=4){a=MX3(a,C0[r],C0[r+1]);b=MX3(b,C0[r+2],C0[r+3]);a=MX3(a,C1[r],C1[r+1]);b=MX3(b,C1[r+2],C1[r+3]);} \
      float rm=__builtin_fmaxf(a,b); { auto rr=__builtin_amdgcn_permlane32_swap(__float_as_uint(rm),__float_as_uint(rm),false,false); rm=__builtin_fmaxf(__uint_as_float(rr[0]),__uint_as_float(rr[1])); } \
      resc=false; \
      if(__builtin_expect(__any(rm>(float)THRL),0)){ const float dl=__builtin_fmaxf(rm,0.f); mhat+=dl; \
        _Pragma("unroll") for(int r=0;r<16;++r){C0[r]-=dl;C1[r]-=dl;} \
        qa=hi?(ft2-mhat):1.f; \
        const float f=__builtin_amdgcn_exp2f(-dl); l_reg*=f; if(hi==0)wsf[r32]=f; resc=true; } } \
    SBAR(); \
    GAPB(o[0]=__builtin_amdgcn_mfma_f32_32x32x16_bf16(PAF(0),VFR(0),o[0],0,0,0), C0,0); \
    GAPB(o[1]=__builtin_amdgcn_mfma_f32_32x32x16_bf16(PAF(0),VFR(4),o[1],0,0,0), C0,4); \
    KRD(GL,0); GAPB(o[0]=__builtin_amdgcn_mfma_f32_32x32x16_bf16(PAF(1),VFR(1),o[0],0,0,0), C0,8); \
    KRD(GL,1); GAPB(o[1]=__builtin_amdgcn_mfma_f32_32x32x16_bf16(PAF(1),VFR(5),o[1],0,0,0), C0,12); \
    KRD(GL,2); GAPB(o[0]=__builtin_amdgcn_mfma_f32_32x32x16_bf16(PAF(2),VFR(2),o[0],0,0,0), C1,0); \
    KRD(GL,3); GAPB(o[1]=__builtin_amdgcn_mfma_f32_32x32x16_bf16(PAF(2),VFR(6),o[1],0,0,0), C1,4); \
    GAPB(o[0]=__builtin_amdgcn_mfma_f32_32x32x16_bf16(PAF(3),VFR(3),o[0],0,0,0), C1,8); \
    GAPB(o[1]=__builtin_amdgcn_mfma_f32_32x32x16_bf16(PAF(3),VFR(7),o[1],0,0,0), C1,12); \
    }while(0)
  int t=1;
  #undef CMASK
  #define CMASK(P0,P1,t) do{}while(0)
  for(;t+5<NT;t+=2){
    STEP(pB0,pB1,pA0,pA1,t,true,true,true);     WAIT_BAR(2); RESC(); ROT();
    STEP(pA0,pA1,pB0,pB1,t+1,true,true,true);   WAIT_BAR(2); RESC(); ROT();
  }
  #undef CMASK
  #define CMASK(P0,P1,t) do{int jb_=(t)-(NT-4); if(jb_>=0)cmask(P0,P1,jb_,qrel,hi);}while(0)
  #define ENDW(tt) do{ if((tt)+3<NT){WAIT_BAR(2);} else if((tt)+2<NT){WAIT_BAR(1);} else {WAIT_BAR(0);} }while(0)
  for(;t+1<NT;t+=2){
    STEP(pB0,pB1,pA0,pA1,t,(t+3<NT),(t+1<NT),(t+1<NT));       ENDW(t);   RESC(); ROT();
    STEP(pA0,pA1,pB0,pB1,t+1,(t+4<NT),(t+2<NT),(t+2<NT));     ENDW(t+1); RESC(); ROT();
  }
  STEP(pB0,pB1,pA0,pA1,NT-1,false,false,false); RESC();
  { float sacc=pB0[0]+pB0[1]; _Pragma("unroll") for(int r=2;r<16;++r)sacc+=pB0[r]; _Pragma("unroll") for(int r=0;r<16;++r)sacc+=pB1[r]; l_reg+=sacc;
    pw0=(u32x4){PKW(pB0,0),PKW(pB0,2),PKW(pB0,4),PKW(pB0,6)};pw1=(u32x4){PKW(pB0,8),PKW(pB0,10),PKW(pB0,12),PKW(pB0,14)};pw2=(u32x4){PKW(pB1,0),PKW(pB1,2),PKW(pB1,4),PKW(pB1,6)};pw3=(u32x4){PKW(pB1,8),PKW(pB1,10),PKW(pB1,12),PKW(pB1,14)};
    SBAR(); pv(o,vb0+sl_cur,PAF(0),PAF(1),PAF(2),PAF(3)); }
  #undef PKW
  #undef PAF
  #undef VFR
  #undef PIN
  #undef MX3
  #undef GAPA
  #undef GAPB
  #undef EX
  #undef VRD
  #undef KRD
  #undef STEP
  #undef ENDW
  #undef KA
  #undef BIASMF
  {auto rr=__builtin_amdgcn_permlane32_swap(__float_as_uint(l_reg),__float_as_uint(l_reg),false,false);l_reg=__uint_as_float(rr[0])+__uint_as_float(rr[1]);}
  if(hi==0)wsf[32+r32]=l_reg;asm volatile("s_waitcnt lgkmcnt(0)":::"memory");
  float rli[16];
  #pragma unroll
  for(int r=0;r<16;++r)rli[r]=__builtin_amdgcn_rcpf(wsf[32+crow(r,hi)]);
  { bf16*stg=(bf16*)(shm+LDS_OST)+wid*2048;
    #pragma unroll
    for(int r=0;r<16;++r){const int orow=crow(r,hi);
      #pragma unroll
      for(int d0=0;d0<2;++d0)stg[orow*64+d0*32+r32]=__float2bfloat16(o[d0][r]*rli[r]);}
    asm volatile("s_waitcnt lgkmcnt(0)":::"memory");
    head_norm_store(stg,O+(rowbase+q0+wid*QBLK)*OD+h*D,G+(rowbase+q0+wid*QBLK)*DM+h*D,gn+h*D,lane); }
  asm volatile("s_waitcnt lgkmcnt(0)\n\ts_barrier":::"memory");
  #undef DMA_K
  #undef DMA_V
  #undef CMASK
  #undef START
  #undef RESC
  #undef ROT
}

__device__ __forceinline__ void sb_wave(int b,int h,int qw,const bf16*Q,const bf16*__restrict__ K,const bf16*__restrict__ V,bf16*O,const float*__restrict__ gn,char*slot,int lane_){
  int lane=lane_; asm volatile("":"+v"(lane));
  const int r32=lane&31,hi=lane>>5;
  const long rowbase=(long)b*SEQ;
  const bf16*Qw=Q+(rowbase+qw)*DM+h*D;
  const bf16*Kh=K+rowbase*DM+h*D,*Vh=V+rowbase*DM+h*D;
  const unsigned lds0=(unsigned)(uintptr_t)slot;
  const int vb0=(int)(lds0+8192)+((lane>>4)&1)*32+(lane&3)*8+(4*hi+((lane&15)>>2))*64;
  bf16x8 qr[4];
  #pragma unroll
  for(int d0=0;d0<4;++d0)qr[d0]=*reinterpret_cast<const bf16x8*>(&Qw[(long)r32*DM+d0*16+hi*8]);
  f32x16 o[2];o[0]=f32x16{};o[1]=f32x16{};
  const f32x16 zero=f32x16{};
  float carry=0.f;
  const int qabs=qw+r32;
  for(int j=(qw+30)>>6;j>=0;--j){
    asm volatile("s_waitcnt lgkmcnt(0)":::"memory");
    #pragma unroll
    for(int w8=0;w8<8;++w8)glds16(Kh+(long)(j*KVBLK+lane)*DM+w8*8,(unsigned)__builtin_amdgcn_readfirstlane(lds0+w8*1024));
    #pragma unroll
    for(int w8=0;w8<8;++w8)glds16(Vh+(long)(j*KVBLK+16*(w8&3)+(lane>>2))*DM+(w8>>2)*32+(lane&3)*8,(unsigned)__builtin_amdgcn_readfirstlane(lds0+8192+w8*1024));
    asm volatile("s_waitcnt vmcnt(0)":::"memory");
    f32x16 p0,p1;
    qkt(p0,p1,slot,qr,zero,r32,hi);
    const int kb=64*j+4*hi;
    float lk0[16],lk1[16];
    #pragma unroll
    for(int r=0;r<16;++r){
      const int kv=kb+(r&3)+8*(r>>2);
      { const float z=p0[r]; const float t=__builtin_amdgcn_logf(1.0f+__builtin_amdgcn_exp2f(-__builtin_fabsf(z))); const bool ok=kv<qabs;
        p0[r]=ok?(__builtin_fminf(z,0.f)-t):-INFINITY; lk0[r]=ok?(__builtin_fminf(-z,0.f)-t):0.f; }
      { const float z=p1[r]; const float t=__builtin_amdgcn_logf(1.0f+__builtin_amdgcn_exp2f(-__builtin_fabsf(z))); const bool ok=(kv+32)<qabs;
        p1[r]=ok?(__builtin_fminf(z,0.f)-t):-INFINITY; lk1[r]=ok?(__builtin_fminf(-z,0.f)-t):0.f; }
    }
    float gs[8],og[8];
    #pragma unroll
    for(int g=0;g<4;++g){gs[g]=(lk0[4*g]+lk0[4*g+1])+(lk0[4*g+2]+lk0[4*g+3]); gs[g+4]=(lk1[4*g]+lk1[4*g+1])+(lk1[4*g+2]+lk1[4*g+3]);}
    #pragma unroll
    for(int g=0;g<8;++g)og[g]=__shfl_xor(gs[g],32);
    float run=carry;
    #pragma unroll
    for(int g=7;g>=0;--g){
      const float base=run+(hi?0.f:og[g]);
      run+=gs[g]+og[g];
      if(g>=4){const int q=4*(g-4); const float l3=base,l2=l3+lk1[q+3],l1=l2+lk1[q+2],l0=l1+lk1[q+1];
        p1[q]=__builtin_amdgcn_exp2f(p1[q]+l0);p1[q+1]=__builtin_amdgcn_exp2f(p1[q+1]+l1);p1[q+2]=__builtin_amdgcn_exp2f(p1[q+2]+l2);p1[q+3]=__builtin_amdgcn_exp2f(p1[q+3]+l3);}
      else{const int q=4*g; const float l3=base,l2=l3+lk0[q+3],l1=l2+lk0[q+2],l0=l1+lk0[q+1];
        p0[q]=__builtin_amdgcn_exp2f(p0[q]+l0);p0[q+1]=__builtin_amdgcn_exp2f(p0[q+1]+l1);p0[q+2]=__builtin_amdgcn_exp2f(p0[q+2]+l2);p0[q+3]=__builtin_amdgcn_exp2f(p0[q+3]+l3);}
    }
    carry=run;
    u32x4 pw0,pw1,pw2,pw3;
    pw0=(u32x4){cvtpk_s(p0[0],p0[1]),cvtpk_s(p0[2],p0[3]),cvtpk_s(p0[4],p0[5]),cvtpk_s(p0[6],p0[7])};
    pw1=(u32x4){cvtpk_s(p0[8],p0[9]),cvtpk_s(p0[10],p0[11]),cvtpk_s(p0[12],p0[13]),cvtpk_s(p0[14],p0[15])};
    pw2=(u32x4){cvtpk_s(p1[0],p1[1]),cvtpk_s(p1[2],p1[3]),cvtpk_s(p1[4],p1[5]),cvtpk_s(p1[6],p1[7])};
    pw3=(u32x4){cvtpk_s(p1[8],p1[9]),cvtpk_s(p1[10],p1[11]),cvtpk_s(p1[12],p1[13]),cvtpk_s(p1[14],p1[15])};
    pv(o,vb0,__builtin_bit_cast(bf16x8,pw0),__builtin_bit_cast(bf16x8,pw1),__builtin_bit_cast(bf16x8,pw2),__builtin_bit_cast(bf16x8,pw3));
    if(__all(carry<-152.0f))break;
  }
  asm volatile("s_waitcnt lgkmcnt(0)":::"memory");
  { bf16*stg=(bf16*)slot;
    #pragma unroll
    for(int r=0;r<16;++r){const int orow=crow(r,hi);
      #pragma unroll
      for(int d0=0;d0<2;++d0)stg[orow*64+d0*32+r32]=__float2bfloat16(o[d0][r]);}
    asm volatile("s_waitcnt lgkmcnt(0)":::"memory");
    head_norm_store(stg,O+(rowbase+qw)*OD+h*D,nullptr,gn+h*D,lane); }
  asm volatile("s_waitcnt lgkmcnt(0)":::"memory");
}
#undef SBAR
#undef WAIT_BAR
}
namespace mk {
constexpr int NWAVES = 8;
constexpr int BATCH = 2, T = 8192, D = 1024, M = BATCH * T, NPROJ = 3584, NIN = 3592, NE = 16, DEPTH = 4, NMODC = 6144;
constexpr int PC_FQ = 0, PC_FK = 512, PC_FV = 1024, PC_FG = 1536, PC_SQ = 2048, PC_SK = 2560, PC_SV = 3072;
constexpr int MO_SHA = 0, MO_SCA = 1024, MO_GA = 2048, MO_SHF = 3072, MO_SCF = 4096, MO_GF = 5120;
constexpr float ALPHA = 1.6817928305074292f, LN_EPS = 1e-5f;
constexpr int HB_ROWS = 36864;

constexpr size_t MiB = 1u << 20;
constexpr size_t WS_CTL = 0, CTL_ZERO_BYTES = 1 * MiB;
constexpr size_t WS_MOD = 1 * MiB, WS_FLOC = 2 * MiB, WS_CT = 2 * MiB + 768 * 1024, WS_LIST = 3 * MiB, WS_TOKS = 4 * MiB, WS_TOKW = 4 * MiB + 256 * 1024;
constexpr size_t WS_WIN = 8 * MiB, WS_WOUT = 36 * MiB, WS_WGU = 44 * MiB, WS_WD = 300 * MiB;
constexpr size_t WS_UA = 428 * MiB, WS_PQ = 460 * MiB, WS_OB = 572 * MiB, WS_YB = 604 * MiB, WS_X1 = 668 * MiB, WS_U2 = 732 * MiB, WS_HB = 764 * MiB, WS_YD = 836 * MiB, WS_XDBG = 908 * MiB, WS_XB = 940 * MiB  , WS_END = 972 * MiB;
constexpr size_t WIN_L = (size_t)NPROJ * D * 2, WOUT_L = (size_t)D * D * 2, WGU_E = (size_t)2048 * D * 2, WGU_L = 16 * WGU_E, WD_E = (size_t)D * D * 2, WD_L = 16 * WD_E;
constexpr int CW_TMO = 0, CW_BAR = 4096, CW_CNT = 8192  , CW_CHK = 16384,
              CW_Q = 12288  , CW_FLAG = 12288 + 1024  ;

constexpr int RING_OFF = 0, RING_BYTES = 131072, LDSCTL_OFF = RING_BYTES, MISC_OFF = LDSCTL_OFF + 1024, LDS_BYTES = 147456;

#define GAS __attribute__((address_space(1)))
#define LAS __attribute__((address_space(3)))
typedef unsigned short bf16;
typedef unsigned v4u __attribute__((ext_vector_type(4)));
typedef float f32x4 __attribute__((ext_vector_type(4)));
typedef GAS unsigned gu32;
#define RLX_AGENT __ATOMIC_RELAXED, __HIP_MEMORY_SCOPE_AGENT
#define LDS_WAIT() asm volatile("s_waitcnt lgkmcnt(0)" ::: "memory")
__device__ __forceinline__ unsigned f2bf(float f) { unsigned u = __builtin_bit_cast(unsigned, f); return (u + 0x7fffu + ((u >> 16) & 1u)) >> 16; }
__device__ __forceinline__ unsigned pk2(float lo, float hi) { return f2bf(lo) | (f2bf(hi) << 16); }
__device__ __forceinline__ float bflo(unsigned w) { return __uint_as_float(w << 16); }
__device__ __forceinline__ float bfhi(unsigned w) { return __uint_as_float(w & 0xffff0000u); }
__device__ __forceinline__ f32x4 up4(unsigned long long p) { return (f32x4){bflo((unsigned)p), bfhi((unsigned)p), bflo((unsigned)(p >> 32)), bfhi((unsigned)(p >> 32))}; }
__device__ __forceinline__ unsigned long long pk4(const f32x4 v) { return (unsigned long long)pk2(v[0], v[1]) | ((unsigned long long)pk2(v[2], v[3]) << 32); }

#define XB_TMO      128
#define XB_XCNT(j)  (256  + 64 * (j))
#define XB_XSUB(j)  (1280 + 64 * (j))
#define XB_XGEN(j)  (2304 + 64 * (j))
#define XB_TOP      3328
#define XB_TOPGEN   3392
#define XCD_BAR_WORDS 3456
#define XB_SPIN_CAP (1u << 18)
__device__ __forceinline__ unsigned xb_ld(unsigned* p)              { return __hip_atomic_load(p, __ATOMIC_RELAXED, __HIP_MEMORY_SCOPE_AGENT); }
__device__ __forceinline__ unsigned xb_add(unsigned* p, unsigned v) { return __hip_atomic_fetch_add(p, v, __ATOMIC_RELAXED, __HIP_MEMORY_SCOPE_AGENT); }
__device__ __forceinline__ unsigned xb_xcc_id() { return (unsigned)__builtin_amdgcn_s_getreg((3 << 11) | 20) & 0xFu; }
#define XB_SPIN(cond, bar) do { unsigned _sp = 0; while (cond) { __builtin_amdgcn_s_sleep(1); \
    if ((++_sp & 255u) == 0u) { if (xb_ld(&(bar)[XB_TMO])) break; if (_sp > XB_SPIN_CAP) { atomicAdd(&(bar)[XB_TMO], 1u); break; } } } } while (0)
struct XcdBarrier { unsigned* bar; unsigned x; volatile LAS unsigned* st; };
__device__ __forceinline__ XcdBarrier xcd_barrier_post(unsigned* bar, volatile LAS unsigned* st) {
    XcdBarrier b; b.bar = bar; b.x = xb_xcc_id(); b.st = st;
    if (threadIdx.x == 0) (void)xb_add(&bar[XB_XCNT(b.x)], 1u);
    return b;
}
__device__ __forceinline__ void xcd_barrier_complete(unsigned* bar, unsigned x, unsigned& nloc, unsigned& nx) {
    const unsigned G = gridDim.x * gridDim.y * gridDim.z;
    unsigned sum, cnt, mine, sp = 0u;
    for (;;) {
        sum = 0u; cnt = 0u; mine = 0u;
#pragma unroll
        for (unsigned j = 0; j < 16; ++j) { const unsigned c = xb_ld(&bar[XB_XCNT(j)]); sum += c; cnt += (c > 0u) ? 1u : 0u; mine = (j == x) ? c : mine; }
        if (sum == G) break;
        __builtin_amdgcn_s_sleep(1);
        if ((++sp & 255u) == 0u) { if (xb_ld(&bar[XB_TMO])) break; if (sp > XB_SPIN_CAP) { atomicAdd(&bar[XB_TMO], 1u); break; } }
    }
    nloc = mine > 0u ? mine : 1u; nx = cnt > 0u ? cnt : 1u;
}
__device__ __forceinline__ void xcd_barrier(const XcdBarrier& b) {
    asm volatile("s_waitcnt vmcnt(0)" ::: "memory");
    __syncthreads();
    if (threadIdx.x == 0) {
        unsigned* bar = b.bar;
        __builtin_amdgcn_s_waitcnt(0);
        unsigned nloc = b.st[0], nx = b.st[1];
        if (nloc == 0u) { xcd_barrier_complete(bar, b.x, nloc, nx); b.st[0] = nloc; b.st[1] = nx; }
        const unsigned old = xb_add(&bar[XB_XSUB(b.x)], 1u);
        const unsigned gen = old / nloc;
        if (old + 1u == (gen + 1u) * nloc) {
            __builtin_amdgcn_fence(__ATOMIC_RELEASE, "agent");
            asm volatile("s_waitcnt vmcnt(0)" ::: "memory");
            const unsigned og = xb_add(&bar[XB_TOP], 1u);
            const unsigned tg = og / nx;
            if (og + 1u == (tg + 1u) * nx) xb_add(&bar[XB_TOPGEN], 1u);
            else XB_SPIN(xb_ld(&bar[XB_TOPGEN]) == tg, bar);
            __builtin_amdgcn_fence(__ATOMIC_ACQUIRE, "agent");
            xb_add(&bar[XB_XGEN(b.x)], 1u);
            asm volatile("s_waitcnt vmcnt(0)" ::: "memory");
        } else {
            XB_SPIN(xb_ld(&bar[XB_XGEN(b.x)]) == gen, bar);
            __builtin_amdgcn_fence(__ATOMIC_ACQUIRE, "agent");
            asm volatile("s_waitcnt vmcnt(0)" ::: "memory");
        }
    }
    __syncthreads();
}

struct Args {
    const float *x, *c, *w_mod, *b_mod, *w_in, *b_forget, *out_norm_g, *w_out, *ln1_g, *ln1_b, *w_router, *b_router, *w_gate, *w_up, *w_down, *ln2_g, *ln2_b;
    float* out; unsigned char* ws; int ph_lo, ph_hi, use_bar, pad;
};
#define AS4 __attribute__((address_space(4)))
__device__ __forceinline__ void load_args(Args& a) {
#if defined(__HIP_DEVICE_COMPILE__)
    const AS4 unsigned long long* k = (const AS4 unsigned long long*)__builtin_amdgcn_kernarg_segment_ptr(); asm volatile("" : "+s"(k));
#define MK_LDP(i, field) a.field = (decltype(a.field))(GAS void*)k[i]
    MK_LDP(0, x); MK_LDP(1, c); MK_LDP(2, w_mod); MK_LDP(3, b_mod); MK_LDP(4, w_in); MK_LDP(5, b_forget); MK_LDP(6, out_norm_g); MK_LDP(7, w_out); MK_LDP(8, ln1_g); MK_LDP(9, ln1_b);
    MK_LDP(10, w_router); MK_LDP(11, b_router); MK_LDP(12, w_gate); MK_LDP(13, w_up); MK_LDP(14, w_down); MK_LDP(15, ln2_g); MK_LDP(16, ln2_b); MK_LDP(17, out); MK_LDP(18, ws);
#undef MK_LDP
    a.ph_lo = 0; a.ph_hi = 0; a.use_bar = 0; a.pad = 0;
#endif
}
constexpr int N_PHASES = 2 + 7 * DEPTH;

__device__ __forceinline__ float wave_sum(float v) {
#pragma unroll
    for (int o = 1; o < 64; o <<= 1) v += __shfl_xor(v, o);
    return v;
}
__device__ __forceinline__ float sel_m(float a0, float a1, unsigned long long m) { float r; asm("v_cndmask_b32 %0, %1, %2, %3" : "=v"(r) : "v"(a0), "v"(a1), "s"(m)); return r; }
__device__ __forceinline__ float log_sigmoid_f(float z) { return fminf(z, 0.f) - log1pf(expf(-fabsf(z))); }

struct TrSrc { const float* W; int ldw; bf16* dst; };
__device__ __forceinline__ void tr_load(const TrSrc& s, int lane, f32x4 (&v)[8]) {
#pragma unroll
    for (int i = 0; i < 8; ++i) v[i] = *(const GAS f32x4*)(s.W + (size_t)(8 * i + (lane >> 3)) * s.ldw + 4 * (lane & 7));
}
__device__ __forceinline__ void tr_finish(const f32x4 (&v)[8], bf16* __restrict__ WT, LAS float* scr, int lane) {
#pragma unroll
    for (int i = 0; i < 8; ++i) { LAS float* d = scr + (8 * i + (lane >> 3)) * 33 + 4 * (lane & 7); d[0] = v[i][0]; d[1] = v[i][1]; d[2] = v[i][2]; d[3] = v[i][3]; }
    LDS_WAIT(); asm volatile("" ::: "memory");
    const int c = lane & 7;
#pragma unroll
    for (int j = 0; j < 4; ++j) { const int n = (lane >> 3) + 8 * j; const LAS float* s = scr + (8 * c) * 33 + n;
        v4u o; o.x = pk2(s[0 * 33], s[1 * 33]); o.y = pk2(s[2 * 33], s[3 * 33]); o.z = pk2(s[4 * 33], s[5 * 33]); o.w = pk2(s[6 * 33], s[7 * 33]);
        *(GAS v4u*)(WT + (size_t)n * D + 8 * c) = o; }
    LDS_WAIT(); asm volatile("" ::: "memory");
}
constexpr int IT_WINA = 1024, IT_WINB = 768, IT_WOUT = 512, IT_EXP = 1536, IT_LAYER = IT_WINA + IT_WINB + IT_WOUT + 16 * IT_EXP;
__device__ __forceinline__ TrSrc conv_addr(const Args& a, int l, int r) {
    unsigned char* ws = a.ws; TrSrc s;
    if (r < IT_WINA) { const int kb = r / 64, nb = r % 64; s.W = a.w_in + (size_t)l * D * NIN + (size_t)(64 * kb) * NIN + 32 * nb; s.ldw = NIN; s.dst = (bf16*)(ws + WS_WIN + l * WIN_L) + (size_t)(32 * nb) * D + 64 * kb; return s; }
    r -= IT_WINA;
    if (r < IT_WINB) { const int kb = r / 48, nb = r % 48; s.W = a.w_in + (size_t)l * D * NIN + (size_t)(64 * kb) * NIN + 2056 + 32 * nb; s.ldw = NIN; s.dst = (bf16*)(ws + WS_WIN + l * WIN_L) + (size_t)(2048 + 32 * nb) * D + 64 * kb; return s; }
    r -= IT_WINB;
    if (r < IT_WOUT) { const int kb = r / 32, nb = r % 32; s.W = a.w_out + (size_t)l * D * D + (size_t)(64 * kb) * D + 32 * nb; s.ldw = D; s.dst = (bf16*)(ws + WS_WOUT + l * WOUT_L) + (size_t)(32 * nb) * D + 64 * kb; return s; }
    r -= IT_WOUT;
    const int e = r / IT_EXP, q = r % IT_EXP, which = q / 512, qq = q % 512, kb = qq / 32, nb = qq % 32;
    const size_t so = ((size_t)(l * NE + e) * D + 64 * kb) * D + 32 * nb; s.ldw = D;
    if (which == 2) { s.W = a.w_down + so; s.dst = (bf16*)(ws + WS_WD + l * WD_L + e * WD_E) + (size_t)(32 * nb) * D + 64 * kb; }
    else { const int j0 = 32 * nb, row = 256 * (j0 >> 7) + (j0 & 127) + (which ? 128 : 0); s.W = (which ? a.w_up : a.w_gate) + so; s.dst = (bf16*)(ws + WS_WGU + l * WGU_L + e * WGU_E) + (size_t)row * D + 64 * kb; }
    return s;
}
__device__ __forceinline__ void p0_weights(LAS unsigned char* lds, int gw, int NGW, int wave, int lane) {
    Args a; load_args(a);
    LAS float* scr = (LAS float*)(lds + RING_OFF + 32768 + wave * 8704);
    f32x4 v[8]; TrSrc s = conv_addr(a, 0, gw); tr_load(s, lane, v);
#pragma unroll 1
    for (int it = gw; it < IT_LAYER; it += NGW) {
        f32x4 vn[8]; TrSrc sn = s; const bool more = it + NGW < IT_LAYER;
        if (more) { sn = conv_addr(a, 0, it + NGW); tr_load(sn, lane, vn); }
        tr_finish(v, s.dst, scr, lane);
        if (more) {
#pragma unroll
            for (int i = 0; i < 8; ++i) v[i] = vn[i];
            s = sn; }
    }
}
constexpr int Q_PER = 32, Q_CHUNKS = IT_LAYER / Q_PER, Q_CHUNKS_WIO = (IT_WINA + IT_WINB + IT_WOUT) / Q_PER;
__device__ __forceinline__ void conv_pull(LAS unsigned char* lds, int L, int upto, int flag_idx  , int tid, int wave, int lane) {
    if (L < 1 || L >= DEPTH) return;
    Args a; load_args(a);
    unsigned* ctl = (unsigned*)(a.ws + WS_CTL);
    unsigned* q = ctl + CW_Q + 64 * L;
    LAS float* scr = (LAS float*)(lds + RING_OFF + 32768 + wave * 8704);
    volatile LAS unsigned* bc = (volatile LAS unsigned*)(lds + LDSCTL_OFF + 960);
    for (;;) {
        __syncthreads();
        if (tid == 0) { unsigned c = 0xffffffffu;
            const bool stop = flag_idx >= 0 && __hip_atomic_load(ctl + CW_FLAG + 64 * flag_idx, RLX_AGENT) != 0u;
            if (!stop && __hip_atomic_load(q, RLX_AGENT) < (unsigned)upto) c = __hip_atomic_fetch_add(q, 1u, RLX_AGENT);
            *bc = c; }
        __syncthreads();
        const unsigned c = *bc;
        if (c >= (unsigned)Q_CHUNKS) break;
        { const int base = (int)c * Q_PER + wave; f32x4 v0[8], v1[8];
          TrSrc s0 = conv_addr(a, L, base), s1 = conv_addr(a, L, base + NWAVES), s2 = conv_addr(a, L, base + 2 * NWAVES), s3 = conv_addr(a, L, base + 3 * NWAVES);
          tr_load(s0, lane, v0); tr_load(s1, lane, v1); tr_finish(v0, s0.dst, scr, lane);
          tr_load(s2, lane, v0); tr_finish(v1, s1.dst, scr, lane);
          tr_load(s3, lane, v1); tr_finish(v0, s2.dst, scr, lane);
          tr_finish(v1, s3.dst, scr, lane); }
    }
}
__device__ __forceinline__ void gemm_tail(LAS unsigned char* lds, int total, int G, int c, int L1, int L2, int flag_idx, int tid, int wave, int lane) {
    const int i_last = (total - 1) / G; const bool late = (i_last * G + c) < total;
    if (late) { if (tid == 0) { Args a; load_args(a); __hip_atomic_store((unsigned*)(a.ws + WS_CTL) + CW_FLAG + 64 * flag_idx, 1u, RLX_AGENT); } }
#if !defined(NO_TAIL_PULL)
    else { conv_pull(lds, L1, Q_CHUNKS, flag_idx, tid, wave, lane); conv_pull(lds, L2, Q_CHUNKS, flag_idx, tid, wave, lane); }
#endif
}
__device__ __forceinline__ void p0_mod(LAS unsigned char* lds, int item, int tid, int wave, int lane) {
    Args a; load_args(a);
    LAS float* cond = (LAS float*)(lds + RING_OFF);
    LAS float* red = (LAS float*)(lds + RING_OFF + 8192);
    for (int i = tid; i < 2 * D; i += NWAVES * 64) { const float cv = a.c[i]; cond[i] = cv / (1.f + expf(-cv)); }
    __syncthreads();
    const int l = item / 24, n0 = (item % 24) * 256;
    const float* w = a.w_mod + (size_t)l * D * NMODC + n0 + 4 * lane;
    f32x4 a0 = {0.f, 0.f, 0.f, 0.f}, a1 = {0.f, 0.f, 0.f, 0.f};
#pragma unroll 8
    for (int k = wave * 128; k < wave * 128 + 128; ++k) { const f32x4 wv = *(const f32x4*)(w + (size_t)k * NMODC); a0 += wv * cond[k]; a1 += wv * cond[D + k]; }
    *(LAS f32x4*)(red + (wave * 2 + 0) * 256 + 4 * lane) = a0; *(LAS f32x4*)(red + (wave * 2 + 1) * 256 + 4 * lane) = a1;
    __syncthreads();
    { const int b = tid >> 8, n = tid & 255; float s = 0.f;
#pragma unroll
        for (int wv = 0; wv < 8; ++wv) s += red[(wv * 2 + b) * 256 + n];
        ((float*)(a.ws + WS_MOD))[(size_t)(l * 2 + b) * NMODC + n0 + n] = s + a.b_mod[l * NMODC + n0 + n]; }
    __syncthreads();
}

__device__ __forceinline__ void prep_load(LAS float* vsc, LAS float* vsh, const Args& a, int l, int b, int tid) {
    const float* mo = (const float*)(a.ws + WS_MOD) + (size_t)(l * 2 + b) * NMODC;
    for (int i = tid; i < D; i += NWAVES * 64) { vsc[i] = mo[MO_SCA + i]; vsh[i] = mo[MO_SHA + i]; }
}
__device__ __forceinline__ void prep_wf(const Args& a, int l, LAS float* wfT, int tid) {
    for (int i = tid; i < 8 * D; i += NWAVES * 64) { const int k = i >> 3, h = i & 7; wfT[h * D + k] = a.w_in[(size_t)l * D * NIN + (size_t)k * NIN + 2048 + h]; }
}
__device__ __forceinline__ void prep_row(const LAS float* vsc, const LAS float* vsh, const LAS float* wfT, const f32x4 (&x)[4], int m, int rl, const float* __restrict__ bfor, bf16* __restrict__ UA, LAS float* lfs, int lane) {
    float dots[8];
#pragma unroll
    for (int h = 0; h < 8; ++h) dots[h] = 0.f;
    GAS unsigned long long* o8 = (GAS unsigned long long*)(UA + (size_t)m * D) + lane;
#pragma unroll
    for (int j = 0; j < 4; ++j) { const f32x4 u = x[j] * (1.f + *(const LAS f32x4*)(vsc + 256 * j + 4 * lane)) + *(const LAS f32x4*)(vsh + 256 * j + 4 * lane);
        o8[64 * j] = (unsigned long long)pk2(u[0], u[1]) | ((unsigned long long)pk2(u[2], u[3]) << 32);
#pragma unroll
        for (int h = 0; h < 8; ++h) { const f32x4 w = *(const LAS f32x4*)(wfT + h * D + 256 * j + 4 * lane); dots[h] += (u[0] * w[0] + u[1] * w[1]) + (u[2] * w[2] + u[3] * w[3]); }
        __builtin_amdgcn_sched_barrier(0); }
#pragma unroll
    for (int s = 0; s < 3; ++s) { const int half = 4 >> s; const unsigned long long mk = s == 0 ? 0xAAAAAAAAAAAAAAAAull : s == 1 ? 0xCCCCCCCCCCCCCCCCull : 0xF0F0F0F0F0F0F0F0ull;
#pragma unroll
        for (int i = 0; i < half; ++i) { const float keep = sel_m(dots[i], dots[half + i], mk), send = sel_m(dots[half + i], dots[i], mk); dots[i] = keep + __shfl_xor(send, 1 << s); } }
    float tot = dots[0];
    tot += __shfl_xor(tot, 8); tot += __shfl_xor(tot, 16); tot += __shfl_xor(tot, 32);
    if (lane < 8) { const int h = 4 * (lane & 1) + 2 * ((lane >> 1) & 1) + ((lane >> 2) & 1); lfs[rl * 8 + h] = log_sigmoid_f(tot + bfor[h]); }
}
__device__ __forceinline__ void prep_scan(const Args& a, LAS float* lfs, int m0, int wave, int lane) {
    if (wave == 0) {
        const int b = m0 / T, t0 = m0 % T; float* floc = (float*)(a.ws + WS_FLOC); float* ct = (float*)(a.ws + WS_CT);
#pragma unroll
        for (int h = 0; h < 8; ++h) { float v = lfs[lane * 8 + h];
#pragma unroll
            for (int o = 1; o < 64; o <<= 1) { const float t = __shfl_up(v, o); if (lane >= o) v += t; }
            floc[(size_t)(b * 8 + h) * T + t0 + lane] = v; if (lane == 63) ct[(b * 8 + h) * 128 + (t0 >> 6)] = v; }
    }
}
__device__ __forceinline__ void phase_prep0(LAS unsigned char* lds, int G, int tid, int wave, int lane) {
    Args a; load_args(a);
    LAS float* lfs = (LAS float*)(lds + RING_OFF); LAS float* wfT = (LAS float*)(lds + RING_OFF + 4096); LAS float* vsc = (LAS float*)(lds + RING_OFF + 36864); LAS float* vsh = vsc + D;
    prep_wf(a, 0, wfT, tid);
    for (int rb = blockIdx.x; rb < M / 64; rb += G) {
        const int m0 = rb * 64, b = m0 / T;
        prep_load(vsc, vsh, a, 0, b, tid);
        __syncthreads();
#pragma unroll 1
        for (int i = 0; i < 8; ++i) { const int rl = wave * 8 + i, m = m0 + rl; f32x4 x[4];
#pragma unroll
            for (int j = 0; j < 4; ++j) x[j] = *(const f32x4*)(a.x + (size_t)m * D + 256 * j + 4 * lane);
            prep_row(vsc, vsh, wfT, x, m, rl, a.b_forget, (bf16*)(a.ws + WS_UA), lfs, lane); }
        __syncthreads();
        prep_scan(a, lfs, m0, wave, lane);
        __syncthreads();
    }
}

template <bool FIRST>
__device__ __forceinline__ void phase_ln1_router(int l, LAS unsigned char* lds, int G, int tid_, int wave, int lane_) {
    int tid = tid_, lane = lane_; asm volatile("" : "+v"(tid), "+v"(lane));
    Args a; load_args(a); const float* __restrict__ Xin = a.x; const bf16* __restrict__ XBin = (const bf16*)(a.ws + WS_XB);
    LAS float* wrT = (LAS float*)(lds + RING_OFF);
    LAS float* lgs = (LAS float*)(lds + RING_OFF + 65536);
    LAS int* rinfo = (LAS int*)(lds + RING_OFF + 65536 + 4096);
    LAS float* rw = (LAS float*)(lds + RING_OFF + 65536 + 4096 + 1024);
    LAS int* lcnt = (LAS int*)(lds + RING_OFF + 65536 + 4096 + 2048);
    LAS float* vga = (LAS float*)(lds + RING_OFF + 65536 + 8192); LAS float* vscf = vga + D; LAS float* vshf = vscf + D; LAS float* vlg = vshf + D; LAS float* vlb = vlg + D;
    for (int i = tid; i < NE * D; i += NWAVES * 64) { const int k = i >> 4, e = i & 15; wrT[e * D + k] = a.w_router[i]; }
    unsigned char* ws = a.ws;
    const bf16* YB = (const bf16*)(ws + WS_YB); bf16* X1 = (bf16*)(ws + WS_X1); bf16* U2 = (bf16*)(ws + WS_U2);
    int* list = (int*)(ws + WS_LIST); int* toks = (int*)(ws + WS_TOKS); float* tokw = (float*)(ws + WS_TOKW);
    unsigned* cntg = (unsigned*)(ws + WS_CTL) + CW_CNT + l * 16 * 64;
    for (int rb = blockIdx.x; rb < M / 64; rb += G) {
        const int m0 = rb * 64, b = m0 / T;
        if (tid < 32) lcnt[tid] = 0;
        const float* mo = (const float*)(ws + WS_MOD) + (size_t)(l * 2 + b) * NMODC;
        for (int i = tid; i < D; i += NWAVES * 64) { vga[i] = 1.f + mo[MO_GA + i]; vscf[i] = 1.f + mo[MO_SCF + i]; vshf[i] = mo[MO_SHF + i]; vlg[i] = a.ln1_g[l * D + i]; vlb[i] = a.ln1_b[l * D + i]; }
        __syncthreads();
        f32x4 bxi[2][4]; unsigned long long bx8[2][4], by8[2][4];
#define LN1_ISSUE(i, B) do { _Pragma("unroll") for (int j = 0; j < 4; ++j) { const size_t o_ = (size_t)(m0 + wave * 8 + (i)) * D + 256 * j + 4 * lane; \
            if constexpr (FIRST) bxi[B][j] = *(const GAS f32x4*)(Xin + o_); else bx8[B][j] = *(const GAS unsigned long long*)(XBin + o_); by8[B][j] = *(const GAS unsigned long long*)(YB + o_); } } while (0)
        LN1_ISSUE(0, 0);
#pragma unroll
        for (int i = 0; i < 8; ++i) {
            const int rl = wave * 8 + i, m = m0 + rl, B = i & 1; f32x4 v[4]; float s = 0.f;
            if (i + 1 < 8) { LN1_ISSUE(i + 1, (i + 1) & 1); }
            __builtin_amdgcn_sched_barrier(0);
#pragma unroll
            for (int j = 0; j < 4; ++j) { f32x4 xin; if constexpr (FIRST) xin = bxi[B][j]; else xin = up4(bx8[B][j]);
                v[j] = ALPHA * xin + *(const LAS f32x4*)(vga + 256 * j + 4 * lane) * up4(by8[B][j]); s += (v[j][0] + v[j][1]) + (v[j][2] + v[j][3]); }
            const float mu = wave_sum(s) * (1.f / D); float q = 0.f;
#pragma unroll
            for (int j = 0; j < 4; ++j) { v[j] = v[j] - mu; q += (v[j][0] * v[j][0] + v[j][1] * v[j][1]) + (v[j][2] * v[j][2] + v[j][3] * v[j][3]); }
            const float rstd = 1.f / sqrtf(wave_sum(q) * (1.f / D) + LN_EPS);
            float lgt[16];
#pragma unroll
            for (int e = 0; e < 16; ++e) lgt[e] = 0.f;
            GAS unsigned long long* o8 = (GAS unsigned long long*)(U2 + (size_t)m * D) + lane;
#pragma unroll
            for (int j = 0; j < 4; ++j) { const int kk = 256 * j + 4 * lane; const f32x4 x1 = v[j] * rstd * *(const LAS f32x4*)(vlg + kk) + *(const LAS f32x4*)(vlb + kk); *(GAS unsigned long long*)(X1 + (size_t)m * D + kk) = pk4(x1);
                const f32x4 u = x1 * *(const LAS f32x4*)(vscf + kk) + *(const LAS f32x4*)(vshf + kk);
                o8[64 * j] = (unsigned long long)pk2(u[0], u[1]) | ((unsigned long long)pk2(u[2], u[3]) << 32);
#pragma unroll
                for (int e = 0; e < 16; ++e) { const f32x4 w = *(const LAS f32x4*)(wrT + e * D + 256 * j + 4 * lane); lgt[e] += (u[0] * w[0] + u[1] * w[1]) + (u[2] * w[2] + u[3] * w[3]); if ((e & 3) == 3) __builtin_amdgcn_sched_barrier(0); } }
#pragma unroll
            for (int s2 = 0; s2 < 4; ++s2) { const int half = 8 >> s2; const unsigned long long mk = s2 == 0 ? 0xAAAAAAAAAAAAAAAAull : s2 == 1 ? 0xCCCCCCCCCCCCCCCCull : s2 == 2 ? 0xF0F0F0F0F0F0F0F0ull : 0xFF00FF00FF00FF00ull;
#pragma unroll
                for (int k = 0; k < half; ++k) { const float keep = sel_m(lgt[k], lgt[half + k], mk), send = sel_m(lgt[half + k], lgt[k], mk); lgt[k] = keep + __shfl_xor(send, 1 << s2); } }
            float tot = lgt[0]; tot += __shfl_xor(tot, 16); tot += __shfl_xor(tot, 32);
            if (lane < 16) { const int e = 8 * (lane & 1) + 4 * ((lane >> 1) & 1) + 2 * ((lane >> 2) & 1) + ((lane >> 3) & 1); lgs[rl * 16 + e] = tot; }
            __builtin_amdgcn_sched_barrier(0);
        }
#undef LN1_ISSUE
        LDS_WAIT();
        if (lane < 8) {
            const int rl = wave * 8 + lane; const LAS float* L = lgs + rl * 16;
            float mx = L[0];
            for (int e = 1; e < 16; ++e) mx = fmaxf(mx, L[e]);
            float sum = 0.f;
            for (int e = 0; e < 16; ++e) sum += expf(L[e] - mx);
            const float inv = 1.f / sum;
            int bg = 0; float bgs = -INFINITY;
            for (int g = 0; g < 4; ++g) { float t1 = -INFINITY, t2 = -INFINITY;
                for (int k = 0; k < 4; ++k) { const float sv = expf(L[g * 4 + k] - mx) * inv + a.b_router[g * 4 + k]; if (sv > t1) { t2 = t1; t1 = sv; } else if (sv > t2) t2 = sv; }
                const float gs = t1 + t2; if (gs > bgs) { bgs = gs; bg = g; } }
            int i0 = 0, i1 = 0; float t1 = -INFINITY, t2 = -INFINITY, p0 = 0.f, p1 = 0.f;
            for (int k = 0; k < 4; ++k) { const int e = bg * 4 + k; const float pr = expf(L[e] - mx) * inv, sv = pr + a.b_router[e];
                if (sv > t1) { t2 = t1; i1 = i0; p1 = p0; t1 = sv; i0 = e; p0 = pr; } else if (sv > t2) { t2 = sv; i1 = e; p1 = pr; } }
            const int r0 = atomicAdd((int*)&lcnt[i0], 1), r1 = atomicAdd((int*)&lcnt[i1], 1);
            rinfo[rl * 4 + 0] = i0; rinfo[rl * 4 + 1] = i1; rinfo[rl * 4 + 2] = r0; rinfo[rl * 4 + 3] = r1;
            const float wsum = p0 + p1; rw[rl * 2] = p0 / wsum; rw[rl * 2 + 1] = p1 / wsum;
        }
        __syncthreads();
        if (tid < 16) { const int n = lcnt[tid]; lcnt[16 + tid] = n ? (int)__hip_atomic_fetch_add(cntg + tid * 64, (unsigned)n, RLX_AGENT) : 0; }
        __syncthreads();
        if (tid < 64) { const int m = m0 + tid, e0 = rinfo[tid * 4], e1 = rinfo[tid * 4 + 1], q0 = lcnt[16 + e0] + rinfo[tid * 4 + 2], q1 = lcnt[16 + e1] + rinfo[tid * 4 + 3];
            list[(size_t)e0 * M + q0] = m; list[(size_t)e1 * M + q1] = m; toks[m * 2] = (e0 << 16) | q0; toks[m * 2 + 1] = (e1 << 16) | q1; tokw[m * 2] = rw[tid * 2]; tokw[m * 2 + 1] = rw[tid * 2 + 1]; }
        __syncthreads();
    }
}

__device__ __forceinline__ void moe_tables(const Args& a, int l, LAS int* tab, int tid) {
    if (tid == 0) { unsigned* cntg = (unsigned*)(a.ws + WS_CTL) + CW_CNT + l * 16 * 64; int run = 0;
        for (int e = 0; e < NE; ++e) { const int n = (int)__hip_atomic_load(cntg + e * 64, RLX_AGENT); tab[e] = n; tab[16 + e] = run; const int nb = (n + 255) >> 8; for (int k = 0; k < nb; ++k) tab[64 + run + k] = e; run += nb; }
        tab[32] = run; tab[33] = run; }
    __syncthreads();
}
struct MoeSched {
    const pg8::bf16_t* A; const unsigned char* W; const int* list; const LAS int* tab; int NT, G, vcu, K; size_t wstride;
    __device__ __forceinline__ bool next(int i, pg8::Unit& u) const {
        const int L = i * G + vcu; if (L >= tab[33] * NT) return false;
        const int rb = L / NT; u.pm = rb; u.pn = L - rb * NT; u.e = tab[64 + rb]; u.r0 = (rb - tab[16 + u.e]) * 256; u.nv = tab[u.e] - u.r0; return true;
    }
    __device__ __forceinline__ const char* aptr(const pg8::Unit& u) const { return (const char*)A + (size_t)u.pm * (size_t)256 * K * 2; }
    __device__ __forceinline__ const char* bptr(const pg8::Unit& u) const { return (const char*)W + (size_t)u.e * wstride + (size_t)u.pn * (size_t)256 * K * 2; }
    __device__ __forceinline__ void arows4(const pg8::Unit& u, int r, int (&t)[4]) const {
        const GAS int* lp = (const GAS int*)list + (size_t)u.e * M + u.r0; const int last = u.nv - 1;
#pragma unroll
        for (int k = 0; k < 4; ++k) { const int rr = r + 64 * k; t[k] = lp[rr < last ? rr : last]; }
    }
};
struct MoeSchedG : MoeSched {
    __device__ __forceinline__ const char* aptr(const pg8::Unit&) const { return (const char*)A; }
};

template <bool LAST>
__device__ __forceinline__ void phase_combine_ln2(int l, LAS unsigned char* lds, int G, int tid_, int wave, int lane_) {
    int tid = tid_, lane = lane_; asm volatile("" : "+v"(tid), "+v"(lane));
    Args a; load_args(a); float* __restrict__ Xout = a.out; bf16* __restrict__ XBout = (bf16*)(a.ws + WS_XB);
    LAS float* lfs = (LAS float*)(lds + RING_OFF); LAS float* wfT = (LAS float*)(lds + RING_OFF + 4096); LAS float* vsc = (LAS float*)(lds + RING_OFF + 36864); LAS float* vsh = vsc + D;
    LAS float* vgf = vsh + D; LAS float* vlg = vgf + D; LAS float* vlb = vlg + D;
    LAS int* tab = (LAS int*)(lds + LDSCTL_OFF);
    unsigned char* ws = a.ws;
    if (l + 1 < DEPTH) prep_wf(a, l + 1, wfT, tid);
    moe_tables(a, l, tab, tid);
    const bf16* X1 = (const bf16*)(ws + WS_X1); const bf16* YD = (const bf16*)(ws + WS_YD); const int* toks = (const int*)(ws + WS_TOKS); const float* tokw = (const float*)(ws + WS_TOKW);
    const bool nxt = (l + 1 < DEPTH);
    for (int rb = blockIdx.x; rb < M / 64; rb += G) {
        const int m0 = rb * 64, b = m0 / T;
        const float* mo = (const float*)(ws + WS_MOD) + (size_t)(l * 2 + b) * NMODC;
        __syncthreads();
        for (int i = tid; i < D; i += NWAVES * 64) { vgf[i] = 1.f + mo[MO_GF + i]; vlg[i] = a.ln2_g[l * D + i]; vlb[i] = a.ln2_b[l * D + i]; }
        if (nxt) prep_load(vsc, vsh, a, l + 1, b, tid);
        __syncthreads();
        const int mw = m0 + wave * 8;
        const int tkv = toks[mw * 2 + (lane & 15)]; const float twv = tokw[mw * 2 + (lane & 15)];
        unsigned long long bx[2][4], bya[2][4], byb[2][4];
#define CMB_ISSUE(i, B) do { const int s0_ = __builtin_amdgcn_readlane(tkv, 2 * (i)), s1_ = __builtin_amdgcn_readlane(tkv, 2 * (i) + 1); \
            const size_t r0_ = (size_t)(tab[16 + (s0_ >> 16)] * 256 + (s0_ & 0xffff)), r1_ = (size_t)(tab[16 + (s1_ >> 16)] * 256 + (s1_ & 0xffff)); \
            const GAS unsigned long long* y0_ = (const GAS unsigned long long*)(YD + r0_ * D) + lane; const GAS unsigned long long* y1_ = (const GAS unsigned long long*)(YD + r1_ * D) + lane; \
            _Pragma("unroll") for (int j = 0; j < 4; ++j) { bx[B][j] = *(const GAS unsigned long long*)(X1 + (size_t)(mw + (i)) * D + 256 * j + 4 * lane); bya[B][j] = y0_[64 * j]; byb[B][j] = y1_[64 * j]; } } while (0)
        CMB_ISSUE(0, 0);
#pragma unroll
        for (int i = 0; i < 8; ++i) {
            const int rl = wave * 8 + i, m = m0 + rl, B = i & 1;
            if (i + 1 < 8) { CMB_ISSUE(i + 1, (i + 1) & 1); }
            __builtin_amdgcn_sched_barrier(0);
            const float w0 = __builtin_bit_cast(float, __builtin_amdgcn_readlane(__builtin_bit_cast(int, twv), 2 * i)), w1 = __builtin_bit_cast(float, __builtin_amdgcn_readlane(__builtin_bit_cast(int, twv), 2 * i + 1));
            f32x4 v[4]; float s = 0.f;
#pragma unroll
            for (int j = 0; j < 4; ++j) { const unsigned long long p = bya[B][j], q = byb[B][j];
                const f32x4 ya = {bflo((unsigned)p), bfhi((unsigned)p), bflo((unsigned)(p >> 32)), bfhi((unsigned)(p >> 32))}, yb = {bflo((unsigned)q), bfhi((unsigned)q), bflo((unsigned)(q >> 32)), bfhi((unsigned)(q >> 32))};
                v[j] = ALPHA * up4(bx[B][j]) + *(const LAS f32x4*)(vgf + 256 * j + 4 * lane) * (w0 * ya + w1 * yb); s += (v[j][0] + v[j][1]) + (v[j][2] + v[j][3]); }
            const float mu = wave_sum(s) * (1.f / D); float q = 0.f;
#pragma unroll
            for (int j = 0; j < 4; ++j) { v[j] = v[j] - mu; q += (v[j][0] * v[j][0] + v[j][1] * v[j][1]) + (v[j][2] * v[j][2] + v[j][3] * v[j][3]); }
            const float rstd = 1.f / sqrtf(wave_sum(q) * (1.f / D) + LN_EPS);
#pragma unroll
            for (int j = 0; j < 4; ++j) { v[j] = v[j] * rstd * *(const LAS f32x4*)(vlg + 256 * j + 4 * lane) + *(const LAS f32x4*)(vlb + 256 * j + 4 * lane);
                if constexpr (LAST) *(f32x4*)(Xout + (size_t)m * D + 256 * j + 4 * lane) = v[j]; else *(GAS unsigned long long*)(XBout + (size_t)m * D + 256 * j + 4 * lane) = pk4(v[j]); }
            if (nxt) prep_row(vsc, vsh, wfT, v, m, rl, a.b_forget + (l + 1) * 8, (bf16*)(ws + WS_UA), lfs, lane);
            __builtin_amdgcn_sched_barrier(0);
        }
#undef CMB_ISSUE
        if (nxt) { __syncthreads(); prep_scan(a, lfs, m0, wave, lane); __syncthreads(); }
    }
}

#ifndef FOX_THRL
#define FOX_THRL 96
#endif
#ifndef FOX_VAR
#define FOX_VAR 0
#endif
#ifndef REP_INPROJ
#define REP_INPROJ 1
#endif
#ifndef REP_FOX
#define REP_FOX 1
#endif
#ifndef REP_SB
#define REP_SB 1
#endif
#ifndef REP_OUTPROJ
#define REP_OUTPROJ 1
#endif
#ifndef REP_GATEUP
#define REP_GATEUP 1
#endif
#ifndef REP_DOWN
#define REP_DOWN 1
#endif
#ifndef REP_COMB
#define REP_COMB 1
#endif
#ifndef REP_P0
#define REP_P0 1
#endif
#ifndef REP_P1
#define REP_P1 1
#endif

__global__ void __launch_bounds__(NWAVES * 64, 2) mk_fwd(Args args) {
    extern __shared__ __attribute__((aligned(16))) unsigned char lds_raw[];
    LAS unsigned char* lds = (LAS unsigned char*)lds_raw;
    volatile LAS unsigned* MISC = (volatile LAS unsigned*)(lds + MISC_OFF);
    const int tid = threadIdx.x, lane = tid & 63, wave = __builtin_amdgcn_readfirstlane(tid >> 6);
    const int G = gridDim.x; int vcu; { const int bx = blockIdx.x; vcu = (G % 8 == 0) ? (bx % 8) * (G / 8) + bx / 8 : bx; }
    for (int u = tid; u < (LDS_BYTES - LDSCTL_OFF) / 4; u += NWAVES * 64) ((LAS unsigned*)(lds + LDSCTL_OFF))[u] = 0u;
    __syncthreads();
    XcdBarrier bar; bar.bar = (unsigned*)(args.ws + WS_CTL) + CW_BAR; bar.x = 0; bar.st = nullptr;
    if (args.use_bar) bar = xcd_barrier_post((unsigned*)(args.ws + WS_CTL) + CW_BAR, MISC + 8);
    const int lo = args.ph_lo, hi = args.ph_hi;
#define IN(k) (lo <= (k) && (k) < hi)
#if defined(MK_STAMP)
#define STAMP(k) do { if (blockIdx.x == 0 && tid == 0) ((unsigned long long*)(args.ws + WS_CTL + 512 * 1024))[(k) + 1] = __builtin_amdgcn_s_memrealtime(); } while (0)
#else
#define STAMP(k) do { } while (0)
#endif
#define SEAM(k) do { if (IN(k) && IN((k) + 1)) xcd_barrier(bar); STAMP(k); } while (0)
    STAMP(-1);

    if (IN(0)) for (int rp_ = 0; rp_ < REP_P0; ++rp_) {
        for (int it = (int)blockIdx.x; it < DEPTH * 24; it += G) p0_mod(lds, it, tid, wave, lane);
        p0_weights(lds, vcu * NWAVES + wave, G * NWAVES, wave, lane);
    }
    SEAM(0);
    if (IN(1)) for (int rp_ = 0; rp_ < REP_P1; ++rp_) { phase_prep0(lds, G, tid, wave, lane); __syncthreads(); }
    SEAM(1);

#define MK_LAYER(l) { \
        const int pb = 2 + 7 * l; \
        if (IN(pb + 0)) { \
            Args A_; load_args(A_); unsigned char* ws = A_.ws; \
            pg8::DenseSched S; S.init((const pg8::bf16_t*)(ws + WS_UA), (const pg8::bf16_t*)(ws + WS_WIN + l * WIN_L), M, NPROJ, D, G, (int)blockIdx.x); \
            pg8::EpiBf16S E{(pg8::bf16_t*)(ws + WS_PQ), NPROJ, 0x303u, attn_body::C2}; \
            for (int rp_ = 0; rp_ < REP_INPROJ; ++rp_) pg8::gemm_phase<pg8::EpiBf16S, pg8::DenseSched, true, false>(lds + RING_OFF, D, S, E); \
            gemm_tail(lds, (M / 256) * (NPROJ / 256), G, (int)blockIdx.x, l, l + 1, 4 * l + 0, tid, wave, lane); \
        } \
        SEAM(pb + 0); \
        if (IN(pb + 1)) { \
            Args A_; load_args(A_); unsigned char* ws = A_.ws; \
            const attn_body::bf16* PQ = (const attn_body::bf16*)(ws + WS_PQ); attn_body::bf16* OB = (attn_body::bf16*)(ws + WS_OB); \
            const float* gn = A_.out_norm_g + l * D; \
            for (int v = vcu; v < 256; v += G) { \
                const int bh = v >> 4, s = v & 15, b = bh >> 3, h = bh & 7; \
                const float* floc = (const float*)(ws + WS_FLOC) + (size_t)bh * T; const float* ct = (const float*)(ws + WS_CT) + bh * 128; \
                for (int k = 0; k < 2; ++k) { const int qb = (k & 1) ? 31 - s : s; \
                    attn_body::fox_unit<FOX_THRL>(b, h, qb, PQ + PC_FQ, PQ + PC_FK, PQ + PC_FV, PQ + PC_FG, OB, floc, ct, gn, (char*)lds_raw + RING_OFF); } \
                for (int k = 0; k < 2 * (REP_FOX - 1); ++k) { const int qb = (k & 1) ? 31 - s : s;     \
                    attn_body::fox_unit<FOX_THRL, FOX_VAR>(b, h, qb, PQ + PC_FQ, PQ + PC_FK, PQ + PC_FV, PQ + PC_FG, (attn_body::bf16*)(ws + WS_XDBG), floc, ct, gn, (char*)lds_raw + RING_OFF); } \
                for (int k = 0; k < 2 * REP_SB; ++k) { const int qb = (k & 1) ? 31 - s : s; \
                    attn_body::sb_wave(b, h, qb * 256 + wave * 32, PQ + PC_SQ, PQ + PC_SK, PQ + PC_SV, OB + 512, gn + 512, (char*)lds_raw + RING_OFF + wave * 16384, lane); } \
                __syncthreads(); \
            } \
        } \
        SEAM(pb + 1); \
        if (IN(pb + 2)) { \
            Args A_; load_args(A_); unsigned char* ws = A_.ws; \
            pg8::DenseSched S; S.init((const pg8::bf16_t*)(ws + WS_OB), (const pg8::bf16_t*)(ws + WS_WOUT + l * WOUT_L), M, D, D, G, (int)blockIdx.x); \
            pg8::EpiBf16S E{(pg8::bf16_t*)(ws + WS_YB), D, 0u, 1.f}; \
            for (int rp_ = 0; rp_ < REP_OUTPROJ; ++rp_) pg8::gemm_phase<pg8::EpiBf16S, pg8::DenseSched, true, false>(lds + RING_OFF, D, S, E); \
        } \
        SEAM(pb + 2); \
        if (IN(pb + 3)) { conv_pull(lds, l, Q_CHUNKS, -1, tid, wave, lane); phase_ln1_router<(l) == 0>(l, lds, G, tid, wave, lane); } \
        SEAM(pb + 3); \
        if (IN(pb + 4)) { \
            Args A_; load_args(A_); unsigned char* ws = A_.ws; \
            LAS int* tab = (LAS int*)(lds + LDSCTL_OFF); moe_tables(A_, l, tab, tid); \
            MoeSchedG S; S.A = (const pg8::bf16_t*)(ws + WS_U2); S.W = ws + WS_WGU + l * WGU_L; S.list = (const int*)(ws + WS_LIST); S.tab = tab; S.NT = 8; S.G = G; S.vcu = vcu; S.K = D; S.wstride = WGU_E; \
            pg8::EpiGateUp E{(pg8::bf16_t*)(ws + WS_HB), D}; \
            for (int rp_ = 0; rp_ < REP_GATEUP; ++rp_) pg8::gemm_phase<pg8::EpiGateUp, MoeSchedG, true, true>(lds + RING_OFF, D, S, E); \
            gemm_tail(lds, tab[33] * 8, G, vcu, l + 1, 0, 4 * l + 1, tid, wave, lane); \
        } \
        SEAM(pb + 4); \
        if (IN(pb + 5)) { \
            Args A_; load_args(A_); unsigned char* ws = A_.ws; \
            LAS int* tab = (LAS int*)(lds + LDSCTL_OFF); moe_tables(A_, l, tab, tid); \
            MoeSched S; S.A = (const pg8::bf16_t*)(ws + WS_HB); S.W = ws + WS_WD + l * WD_L; S.list = nullptr; S.tab = tab; S.NT = 4; S.G = G; S.vcu = vcu; S.K = D; S.wstride = WD_E; \
            pg8::EpiBf16S E{(pg8::bf16_t*)(ws + WS_YD), D, 0u, 1.f}; \
            for (int rp_ = 0; rp_ < REP_DOWN; ++rp_) pg8::gemm_phase<pg8::EpiBf16S, MoeSched, true, false>(lds + RING_OFF, D, S, E); \
            gemm_tail(lds, tab[33] * 4, G, vcu, l + 1, 0, 4 * l + 2, tid, wave, lane); \
        } \
        SEAM(pb + 5); \
        if (IN(pb + 6)) { conv_pull(lds, l + 1, Q_CHUNKS_WIO, -1, tid, wave, lane); for (int rp_ = 0; rp_ < REP_COMB; ++rp_) { phase_combine_ln2<(l) == DEPTH - 1>(l, lds, G, tid, wave, lane); __syncthreads(); } } \
        SEAM(pb + 6); \
    }
    MK_LAYER(0) MK_LAYER(1) MK_LAYER(2) MK_LAYER(3)
#undef MK_LAYER
#if defined(MK_STAMP)
    {
        xcd_barrier(bar);
        const unsigned long long* ts = (const unsigned long long*)(args.ws + WS_CTL + 512 * 1024);
        const float da = (float)(ts[STAMP_A + 1] - ts[STAMP_A]) * 1e-5f, db = (float)(ts[STAMP_B + 1] - ts[STAMP_B]) * 1e-2f;
        const float d1 = sqrtf(da);
        for (size_t i = (size_t)blockIdx.x * 512 + tid; i < (size_t)M * D / 4; i += (size_t)G * 512) { f32x4 v = ((f32x4*)args.out)[i]; v = v + d1; ((f32x4*)args.out)[i] = v; }
        __syncthreads();
        if (blockIdx.x == 0 && tid == 0) args.out[0] += db;
    }
#endif
#undef IN
#undef SEAM
}

static int g_grid = 0;
static bool mk_setup() {
    if (g_grid) return g_grid > 0;
    int dev = 0, cus = 0, per_cu = 0;
    if (hipGetDevice(&dev) != hipSuccess || hipDeviceGetAttribute(&cus, hipDeviceAttributeMultiprocessorCount, dev) != hipSuccess) { g_grid = -1; return false; }
    if (hipFuncSetAttribute((const void*)mk_fwd, hipFuncAttributeMaxDynamicSharedMemorySize, LDS_BYTES) != hipSuccess) { fprintf(stderr, "mk: hipFuncSetAttribute failed\n"); g_grid = -1; return false; }
    if (hipOccupancyMaxActiveBlocksPerMultiprocessor(&per_cu, (const void*)mk_fwd, NWAVES * 64, LDS_BYTES) != hipSuccess || per_cu < 1) fprintf(stderr, "mk: occupancy query reports %d\n", per_cu);
    (void)hipGetLastError();
    g_grid = cus;
    return true;
}
static void fill_args(Args& a, void* const* d_in, float* out, void* d_ws) {
    const float** f = (const float**)&a;
    for (int i = 0; i < 17; ++i) f[i] = (const float*)d_in[i];
    a.out = out; a.ws = (unsigned char*)d_ws; a.pad = 0;
}
static void launch_range(Args a, int lo, int hi, int use_bar, hipStream_t stream) {
    a.ph_lo = lo; a.ph_hi = hi; a.use_bar = use_bar;
    hipLaunchKernelGGL(mk_fwd, dim3(g_grid), dim3(NWAVES * 64), LDS_BYTES, stream, a);
}
}
extern "C" void kernel_launch(void* const* d_in, const int* in_sizes, int n_in, void* d_out, int out_size, void* d_ws, size_t ws_size, hipStream_t stream) {
    if (!mk::mk_setup()) return;
    if (ws_size < mk::WS_END) { fprintf(stderr, "ws too small\n"); return; }
    (void)hipMemsetAsync((char*)d_ws + mk::WS_CTL, 0, mk::CTL_ZERO_BYTES, stream);
    mk::Args a{}; mk::fill_args(a, d_in, (float*)d_out, d_ws);
    mk::launch_range(a, 0, mk::N_PHASES, 1, stream);
}
```

```cpp
#include <hip/hip_runtime.h>
#include <cstdio>
#include <cstdint>
#include <cmath>
namespace pg8 {
#define PG8_LAS __attribute__((address_space(3)))
typedef unsigned short bf16_t;
typedef short bf16x8 __attribute__((ext_vector_type(8)));
typedef float f32x4 __attribute__((ext_vector_type(4)));
typedef unsigned u32x4 __attribute__((ext_vector_type(4)));
constexpr int BM = 256, BK = 64, HALF = 128, HTB = HALF * BK * 2  , STAGE_BYTES = 8 * HTB, NXCD = 8, WGM = 8;

__host__ __device__ __forceinline__ int lds_byte(int r, int c) { const int st = (r >> 4) * 2 + (c >> 5), rr = r & 15, cc = c & 31, ob = rr * 64 + cc * 2; return st * 1024 + (ob ^ (((ob >> 9) & 1) << 5)); }
__host__ __device__ __forceinline__ void stage_rc(int b, int& R, int& C) { const int st = b / 1024, sb = b % 1024, swz = sb ^ (((sb >> 9) & 1) << 5); R = (st >> 1) * 16 + swz / 64; C = (st & 1) * 32 + (swz % 64) / 2; }
__host__ __device__ __forceinline__ int perm32(int rho) { const int n = rho >> 4, i = rho & 15; return 8 * (i >> 2) + 4 * n + (i & 3); }

struct Unit { int pm, pn, e, r0, nv; };

struct DenseSched {
    const bf16_t* A; const bf16_t* Bt; int K; int nM, nN, nwg, G, c;
    __device__ void init(const bf16_t* A_, const bf16_t* Bt_, int M, int N, int K_, int G_, int c_) { A = A_; Bt = Bt_; K = K_; nM = M / BM; nN = N / BM; nwg = nM * nN; G = G_; c = c_; }
    __device__ __forceinline__ bool next(int i, Unit& u) const {
        const long L = (long)i * G + c; if (L >= nwg) return false;
        int wgid = (int)L; { const int q = nwg / NXCD, r = nwg % NXCD, xcd = wgid % NXCD, off = wgid / NXCD; wgid = (xcd < r ? xcd * (q + 1) : r * (q + 1) + (xcd - r) * q) + off; }
        const int nig = WGM * nN, gid = wgid / nig, fm = gid * WGM, gsz = (nM - fm) < WGM ? (nM - fm) : WGM;
        u.pm = fm + ((wgid % nig) % gsz); u.pn = (wgid % nig) / gsz; u.e = 0; u.r0 = 0; u.nv = 256; return true;
    }
    __device__ __forceinline__ const char* aptr(const Unit& u) const { return (const char*)A + (size_t)u.pm * (size_t)(2 * HALF) * K * 2; }
    __device__ __forceinline__ const char* bptr(const Unit& u) const { return (const char*)Bt + (size_t)u.pn * (size_t)(2 * HALF) * K * 2; }
};

__device__ __forceinline__ unsigned cvt_pk_bf16(float lo, float hi) { unsigned r; asm volatile("v_cvt_pk_bf16_f32 %0, %1, %2" : "=v"(r) : "v"(lo), "v"(hi)); return r; }

struct EpiBf16S {
    static constexpr bool PERM = true;
    bf16_t* O; int ldc; unsigned qmask; float sc_q; unsigned* kmax;
    __device__ __forceinline__ void operator()(const f32x4 (&acc)[2][2][4][2], const Unit& u, int wr, int wc, int fr, int fq) const {
        const int row0 = u.pm * BM + wr * 64 + fr, col0 = u.pn * BM + wc * 32 + 8 * fq;
        const float sc = ((qmask >> u.pn) & 1u) ? sc_q : 1.f;
        if (kmax && (u.pn == 2 || u.pn == 3)) {
            float mx[2] = {0.f, 0.f};
#pragma unroll
            for (int ai = 0; ai < 2; ++ai)
#pragma unroll
                for (int m = 0; m < 4; ++m)
#pragma unroll
                    for (int bj = 0; bj < 2; ++bj) { const f32x4 a = acc[ai][bj][m][0], b = acc[ai][bj][m][1];
                        float s = (a[0] * a[0] + a[1] * a[1]) + (a[2] * a[2] + a[3] * a[3]) + (b[0] * b[0] + b[1] * b[1]) + (b[2] * b[2] + b[3] * b[3]);
                        s += __shfl_xor(s, 16); s += __shfl_xor(s, 32); mx[bj] = __builtin_fmaxf(mx[bj], s); }
#pragma unroll
            for (int bj = 0; bj < 2; ++bj) { float m = mx[bj];
                m = __builtin_fmaxf(m, __shfl_xor(m, 1)); m = __builtin_fmaxf(m, __shfl_xor(m, 2)); m = __builtin_fmaxf(m, __shfl_xor(m, 4)); m = __builtin_fmaxf(m, __shfl_xor(m, 8));
                if (fr == 0 && fq == 0) { const int head = (u.pn - 2) * 4 + 2 * bj + (wc >> 1), bh = (u.pm >= 32 ? 8 : 0) + head;
                    __hip_atomic_fetch_max(kmax + bh * 2 + (wc & 1), __float_as_uint(m), __ATOMIC_RELAXED, __HIP_MEMORY_SCOPE_AGENT); } }
        }
#pragma unroll
        for (int ai = 0; ai < 2; ++ai)
#pragma unroll
            for (int m = 0; m < 4; ++m) { bf16_t* rowp = O + (size_t)(row0 + ai * HALF + m * 16) * ldc + col0;
#pragma unroll
                for (int bj = 0; bj < 2; ++bj) { const f32x4 v0 = acc[ai][bj][m][0] * sc, v1 = acc[ai][bj][m][1] * sc;
                    u32x4 w; w.x = cvt_pk_bf16(v0[0], v0[1]); w.y = cvt_pk_bf16(v0[2], v0[3]); w.z = cvt_pk_bf16(v1[0], v1[1]); w.w = cvt_pk_bf16(v1[2], v1[3]);
                    *(u32x4*)(rowp + bj * HALF) = w; } }
    }
};
struct EpiF32 {
    static constexpr bool PERM = false;
    float* O; int ldc;
    __device__ __forceinline__ void operator()(const f32x4 (&acc)[2][2][4][2], const Unit& u, int wr, int wc, int fr, int fq) const {
        const int row0 = u.pm * BM + wr * 64 + fr, col0 = u.pn * BM + wc * 32 + 4 * fq;
#pragma unroll
        for (int ai = 0; ai < 2; ++ai)
#pragma unroll
            for (int m = 0; m < 4; ++m) { float* rowp = O + (size_t)(row0 + ai * HALF + m * 16) * ldc + col0;
#pragma unroll
                for (int bj = 0; bj < 2; ++bj)
#pragma unroll
                    for (int n = 0; n < 2; ++n) *(f32x4*)(rowp + bj * HALF + n * 16) = acc[ai][bj][m][n]; }
    }
};
struct EpiGateUp {
    static constexpr bool PERM = true;
    bf16_t* O; int ldc;
    __device__ __forceinline__ void operator()(const f32x4 (&acc)[2][2][4][2], const Unit& u, int wr, int wc, int fr, int fq) const {
        const int row0 = u.pm * BM + wr * 64 + fr, col0 = u.pn * HALF + wc * 32 + 8 * fq;
#pragma unroll
        for (int ai = 0; ai < 2; ++ai)
#pragma unroll
            for (int m = 0; m < 4; ++m) { bf16_t* rowp = O + (size_t)(row0 + ai * HALF + m * 16) * ldc + col0;
                float h[8];
#pragma unroll
                for (int n = 0; n < 2; ++n)
#pragma unroll
                    for (int j = 0; j < 4; ++j) { const float g = acc[ai][0][m][n][j], up = acc[ai][1][m][n][j];
                        const float sg = __builtin_amdgcn_rcpf(1.f + __builtin_amdgcn_exp2f(-1.4426950408889634f * g)); h[n * 4 + j] = g * sg * up; }
                u32x4 w; w.x = cvt_pk_bf16(h[0], h[1]); w.y = cvt_pk_bf16(h[2], h[3]); w.z = cvt_pk_bf16(h[4], h[5]); w.w = cvt_pk_bf16(h[6], h[7]);
                *(u32x4*)rowp = w; }
    }
};

template <class Epi, class Sched, bool ALIGN_EPI, bool GATHER>
__device__ __forceinline__ void gemm_phase(PG8_LAS unsigned char* lds, const int K, const Sched& S, const Epi& E) {
    int tid_ = threadIdx.x; asm volatile("" : "+v"(tid_));
    const int tid = tid_, wid = __builtin_amdgcn_readfirstlane(tid >> 6), lane = tid & 63, wr = wid >> 2, wc = wid & 3, fr = lane & 15, fq = lane >> 4;
    const int nt = K / BK;
    unsigned voffB[2]; int RA0; unsigned CA2;
    { int R, C; stage_rc(tid * 16, R, C); RA0 = R; CA2 = (unsigned)C * 2u;
#pragma unroll
      for (int i = 0; i < 2; ++i) { const int Ri = R + 64 * i, Rb = Epi::PERM ? ((Ri & ~31) + perm32(Ri & 31)) : Ri; voffB[i] = (unsigned)(Rb * K + C) * 2u; } }
    const size_t kstep = (size_t)(BK * 2);
    const size_t hstep = (size_t)HALF * K * 2;
    const unsigned ldsw = (unsigned)wid * 1024u;
    const int aoff = lds_byte(wr * 64 + fr, fq * 8), boff = lds_byte(wc * 32 + fr, fq * 8);
#define PG8_SA(b, h) (((b) * 2 + (h)) * HTB)
#define PG8_SB(b, h) ((4 + (b) * 2 + (h)) * HTB)
#define PG8_STAGE(bufoff, gbase, voff) do { _Pragma("unroll") for (int _i = 0; _i < 2; ++_i) \
        __builtin_amdgcn_global_load_lds((const unsigned*)((const char*)(gbase) + (voff)[_i]), (PG8_LAS unsigned*)(lds + (bufoff) + ldsw + _i * 8192), 16, 0, 0); } while (0)
#define PG8_LDA(dst, b, h) do { _Pragma("unroll") for (int m = 0; m < 4; ++m) _Pragma("unroll") for (int k = 0; k < 2; ++k) dst[m][k] = *(const PG8_LAS bf16x8*)(lds + PG8_SA(b, h) + aoff + m * 2048 + k * 1024); } while (0)
#define PG8_LDB(dst, b, h) do { _Pragma("unroll") for (int n = 0; n < 2; ++n) _Pragma("unroll") for (int k = 0; k < 2; ++k) dst[n][k] = *(const PG8_LAS bf16x8*)(lds + PG8_SB(b, h) + boff + n * 2048 + k * 1024); } while (0)
#define PG8_MMA(ai, bj, At, Bt) do { __builtin_amdgcn_s_setprio(1); _Pragma("unroll") for (int m = 0; m < 4; ++m) _Pragma("unroll") for (int n = 0; n < 2; ++n) _Pragma("unroll") for (int k = 0; k < 2; ++k) \
        acc[ai][bj][m][n] = __builtin_amdgcn_mfma_f32_16x16x32_bf16(Bt[n][k], At[m][k], acc[ai][bj][m][n], 0, 0, 0); __builtin_amdgcn_s_setprio(0); } while (0)
#define PG8_WAIT_V(n) asm volatile("s_waitcnt vmcnt(" #n ")" ::: "memory")
#define PG8_WAIT_L(n) asm volatile("s_waitcnt lgkmcnt(" #n ")" ::: "memory")
#define PG8_BAR __builtin_amdgcn_s_barrier()
#define PG8_SCHED __builtin_amdgcn_sched_barrier(0)
    Unit cur, nxt; int ui = 0;
    if (!S.next(0, cur)) return;
    f32x4 acc[2][2][4][2];
    float zf = 0.f; asm volatile("" : "+v"(zf));
#pragma unroll
    for (int a = 0; a < 2; ++a)
#pragma unroll
        for (int b = 0; b < 2; ++b)
#pragma unroll
            for (int m = 0; m < 4; ++m)
#pragma unroll
                for (int n = 0; n < 2; ++n) acc[a][b][m][n] = (f32x4){zf, zf, zf, zf};
    bf16x8 At[4][2], B0[2][2], B1[2][2];
    unsigned oc[2][2], on[2][2];
#define PG8_AOFF(dst, u) do { if constexpr (GATHER) { int _t[4]; S.arows4(u, RA0, _t); \
            _Pragma("unroll") for (int _k = 0; _k < 4; ++_k) dst[_k >> 1][_k & 1] = (unsigned)_t[_k] * (unsigned)(K * 2) + CA2; } \
        else { _Pragma("unroll") for (int _k = 0; _k < 4; ++_k) dst[_k >> 1][_k & 1] = (unsigned)((RA0 + 64 * _k) * K) * 2u + CA2; } } while (0)
    PG8_AOFF(oc, cur);
    const char* cA = S.aptr(cur); const char* cB = S.bptr(cur);
    PG8_STAGE(PG8_SB(0, 0), cB, voffB); PG8_STAGE(PG8_SB(0, 1), cB + hstep, voffB); PG8_STAGE(PG8_SA(0, 0), cA, oc[0]); PG8_STAGE(PG8_SA(0, 1), cA, oc[1]);
    if (wr == 1) PG8_BAR;
    PG8_WAIT_V(2); PG8_BAR;
    PG8_STAGE(PG8_SB(1, 0), cB + kstep, voffB); PG8_STAGE(PG8_SA(1, 0), cA + kstep, oc[0]); PG8_STAGE(PG8_SB(1, 1), cB + hstep + kstep, voffB);
    PG8_WAIT_V(6); PG8_BAR;
    for (;;) {
        const bool has_next = S.next(ui + 1, nxt);
        const char* nA = has_next ? S.aptr(nxt) : cA; const char* nB = has_next ? S.bptr(nxt) : cB;
        if (has_next) { PG8_AOFF(on, nxt); } else {
#pragma unroll
            for (int _h = 0; _h < 2; ++_h)
#pragma unroll
                for (int _i = 0; _i < 2; ++_i) on[_h][_i] = oc[_h][_i]; }
        for (int t = 0; t < nt; t += 2) {
            const bool last = (t == nt - 2);
            const char* a1 = cA + (size_t)(t + 1) * kstep;
            const char* a2 = last ? nA : cA + (size_t)(t + 2) * kstep; const char* b2 = last ? nB : cB + (size_t)(t + 2) * kstep;
            const char* a3 = a2 + kstep; const char* b3 = b2 + kstep;
            unsigned o2[2][2];
#pragma unroll
            for (int _h = 0; _h < 2; ++_h)
#pragma unroll
                for (int _i = 0; _i < 2; ++_i) o2[_h][_i] = last ? on[_h][_i] : oc[_h][_i];
            PG8_LDB(B0, 0, 0); PG8_LDB(B1, 0, 1); PG8_SCHED; PG8_LDA(At, 0, 0); PG8_STAGE(PG8_SA(1, 1), a1, oc[1]);
            PG8_WAIT_V(8); PG8_WAIT_L(0); PG8_BAR; PG8_MMA(0, 0, At, B0); PG8_MMA(0, 1, At, B1); PG8_BAR; PG8_SCHED;
            PG8_LDA(At, 0, 1); PG8_STAGE(PG8_SB(0, 0), b2, voffB); PG8_STAGE(PG8_SB(0, 1), b2 + hstep, voffB); PG8_STAGE(PG8_SA(0, 0), a2, o2[0]);
            PG8_WAIT_V(8); PG8_WAIT_L(0); PG8_BAR; PG8_MMA(1, 0, At, B0); PG8_MMA(1, 1, At, B1); PG8_BAR; PG8_SCHED;
            PG8_LDB(B0, 1, 0); PG8_LDB(B1, 1, 1); PG8_SCHED; PG8_LDA(At, 1, 0); PG8_STAGE(PG8_SA(0, 1), a2, o2[1]);
            PG8_WAIT_V(8); PG8_WAIT_L(0); PG8_BAR; PG8_MMA(0, 0, At, B0); PG8_MMA(0, 1, At, B1); PG8_BAR; PG8_SCHED;
            PG8_LDA(At, 1, 1); PG8_STAGE(PG8_SB(1, 0), b3, voffB); PG8_STAGE(PG8_SB(1, 1), b3 + hstep, voffB); PG8_STAGE(PG8_SA(1, 0), a3, o2[0]);
            PG8_WAIT_V(8); PG8_WAIT_L(0); PG8_BAR; PG8_MMA(1, 0, At, B0); PG8_MMA(1, 1, At, B1); PG8_BAR; PG8_SCHED;
        }
        if constexpr (ALIGN_EPI) { if (wr == 0) PG8_BAR; }
        E(acc, cur, wr, wc, fr, fq);
        if (!has_next) break;
#pragma unroll
        for (int a = 0; a < 2; ++a)
#pragma unroll
            for (int b = 0; b < 2; ++b)
#pragma unroll
                for (int m = 0; m < 4; ++m)
#pragma unroll
                    for (int n = 0; n < 2; ++n) acc[a][b][m][n] = (f32x4){zf, zf, zf, zf};
        cur = nxt; cA = nA; cB = nB; ++ui;
#pragma unroll
        for (int _h = 0; _h < 2; ++_h)
#pragma unroll
            for (int _i = 0; _i < 2; ++_i) oc[_h][_i] = on[_h][_i];
        if constexpr (ALIGN_EPI) { if (wr == 1) PG8_BAR; }
    }
    PG8_WAIT_V(0);
    if constexpr (!ALIGN_EPI) { if (wr == 0) PG8_BAR; }
    PG8_BAR;
#undef PG8_AOFF
#undef PG8_SA
#undef PG8_SB
#undef PG8_STAGE
#undef PG8_LDA
#undef PG8_LDB
#undef PG8_MMA
#undef PG8_WAIT_V
#undef PG8_WAIT_L
#undef PG8_BAR
#undef PG8_SCHED
}
}
#include <hip/hip_bf16.h>
namespace attn_body {
using bf16=__hip_bfloat16;
using bf16x8=__attribute__((ext_vector_type(8)))short;
using s16x4=__attribute__((ext_vector_type(4)))short;
using f32x16=__attribute__((ext_vector_type(16)))float;
using f32x4a=__attribute__((ext_vector_type(4)))float;
using u32x4=__attribute__((ext_vector_type(4)))unsigned;
constexpr int SEQ=8192,D=64,DM=3584,OD=1024;
constexpr int NW=8,QBLK=32,QB=QBLK*NW,KVBLK=64,NQB=SEQ/QB;
__device__ __forceinline__ int crow(int r,int hi){return (r&3)+8*(r>>2)+4*hi;}
#define SBAR() __builtin_amdgcn_sched_barrier(0)
__device__ __forceinline__ void cmask(f32x16&p0,f32x16&p1,int jb,int qrel,int hi){
  const float NEG=-INFINITY; int kb=64*jb+4*hi;
  #pragma unroll
  for(int r=0;r<16;++r){int kv=kb+(r&3)+8*(r>>2); if(kv>qrel)p0[r]=NEG; if(kv+32>qrel)p1[r]=NEG;}
}
constexpr int NSLOT=3, SLOTB=8192;
constexpr int LDS_K=0, LDS_V=NSLOT*SLOTB, LDS_WS=2*NSLOT*SLOTB, LDS_OST=LDS_WS+NW*64*4, LDS_TAB=LDS_OST+NW*4096, LDS_CT=LDS_TAB+SEQ*4, LDS_BYTES=LDS_CT+1024;
constexpr float LOG2E=1.4426950408889634f;
constexpr float C2=0.125f*LOG2E;
__device__ __forceinline__ void glds16(const void*gsrc,unsigned lds_dst){unsigned keep;
  asm volatile("s_mov_b32 %0, m0\n\ts_mov_b32 m0, %2\n\ts_nop 0\n\tglobal_load_lds_dwordx4 %1, off\n\ts_mov_b32 m0, %0":"=&s"(keep):"v"(gsrc),"s"(lds_dst):"memory");}
__device__ __forceinline__ float max3f(float a,float b,float c){float r;asm("v_max3_f32 %0, %1, %2, %3":"=v"(r):"v"(a),"v"(b),"v"(c));return r;}
__device__ __forceinline__ float max2f(float a,float b){float r;asm("v_max_f32_e32 %0, %1, %2":"=v"(r):"v"(a),"v"(b));return r;}
__device__ __forceinline__ float fadd_s(float a,float b){float r;asm("v_add_f32_e32 %0, %1, %2":"=v"(r):"v"(a),"v"(b));return r;}
__device__ __forceinline__ float fsub_s(float a,float b){float r;asm("v_sub_f32_e32 %0, %1, %2":"=v"(r):"v"(a),"v"(b));return r;}
typedef float f32x2_t __attribute__((ext_vector_type(2))); typedef __bf16 bf16x2_t __attribute__((ext_vector_type(2)));
__device__ __forceinline__ unsigned cvtpk_s(float lo,float hi){f32x2_t v={lo,hi};bf16x2_t b=__builtin_convertvector(v,bf16x2_t);return __builtin_bit_cast(unsigned,b);}
__device__ __forceinline__ float bf_lo(unsigned w){return __uint_as_float(w<<16);} __device__ __forceinline__ float bf_hi(unsigned w){return __uint_as_float(w&0xffff0000u);}
#define WAIT_BAR(N) asm volatile("s_waitcnt vmcnt(" #N ") lgkmcnt(0)\n\ts_barrier":::"memory")

__device__ __forceinline__ void qkt(f32x16&p0,f32x16&p1,const char*Kslot,const bf16x8*qr,const f32x16&negm,int r32,int hi){
  const char*kb=Kslot+hi*1024+r32*16;
  #pragma unroll
  for(int d0=0;d0<4;++d0){
    const bf16x8 b0=*reinterpret_cast<const bf16x8*>(kb+d0*2048);
    const bf16x8 b1=*reinterpret_cast<const bf16x8*>(kb+d0*2048+512);
    if(d0==0){p0=__builtin_amdgcn_mfma_f32_32x32x16_bf16(b0,qr[0],negm,0,0,0);p1=__builtin_amdgcn_mfma_f32_32x32x16_bf16(b1,qr[0],negm,0,0,0);}
    else{p0=__builtin_amdgcn_mfma_f32_32x32x16_bf16(b0,qr[d0],p0,0,0,0);p1=__builtin_amdgcn_mfma_f32_32x32x16_bf16(b1,qr[d0],p1,0,0,0);}}
}
typedef __attribute__((address_space(3))) const char* lds_cptr;
typedef short v4i16_t __attribute__((ext_vector_type(4)));
__device__ __forceinline__ void kload8(bf16x8*kf,lds_cptr kp){
  kf[0]=*(const __attribute__((address_space(3))) bf16x8*)(kp);      kf[1]=*(const __attribute__((address_space(3))) bf16x8*)(kp+512);
  kf[2]=*(const __attribute__((address_space(3))) bf16x8*)(kp+2048); kf[3]=*(const __attribute__((address_space(3))) bf16x8*)(kp+2560);
  kf[4]=*(const __attribute__((address_space(3))) bf16x8*)(kp+4096); kf[5]=*(const __attribute__((address_space(3))) bf16x8*)(kp+4608);
  kf[6]=*(const __attribute__((address_space(3))) bf16x8*)(kp+6144); kf[7]=*(const __attribute__((address_space(3))) bf16x8*)(kp+6656);
}
__device__ __forceinline__ void kload2(bf16x8*kf,lds_cptr kp,int j){ kf[2*j]=*(const __attribute__((address_space(3))) bf16x8*)(kp+j*2048); kf[2*j+1]=*(const __attribute__((address_space(3))) bf16x8*)(kp+j*2048+512); }
__device__ __forceinline__ s16x4 vtr(lds_cptr p){ return __builtin_bit_cast(s16x4,__builtin_amdgcn_ds_read_tr16_b64_v4i16((__attribute__((address_space(3))) v4i16_t*)p)); }
__device__ __forceinline__ float rowmax(const f32x16&p0,const f32x16&p1){
  float a=max3f(p0[0],p0[1],p1[0]),b=max3f(p0[2],p0[3],p1[1]);a=max3f(a,p1[2],p1[3]);
  #pragma unroll
  for(int r=4;r<16;r+=4){a=max3f(a,p0[r],p0[r+1]);b=max3f(b,p0[r+2],p0[r+3]);a=max3f(a,p1[r],p1[r+1]);b=max3f(b,p1[r+2],p1[r+3]);}
  const float m=max2f(a,b);
  auto rr=__builtin_amdgcn_permlane32_swap(__float_as_uint(m),__float_as_uint(m),false,false);
  return max2f(__uint_as_float(rr[0]),__uint_as_float(rr[1]));
}
__device__ __forceinline__ void pv(f32x16*o,int vb,bf16x8 pa0,bf16x8 pa1,bf16x8 pa2,bf16x8 pa3){
  #pragma unroll
  for(int d0=0;d0<2;++d0){s16x4 lo[4],hi[4];
    #pragma unroll
    for(int ks=0;ks<4;++ks){
      asm volatile("ds_read_b64_tr_b16 %0,%1 offset:%c2":"=&v"(lo[ks]):"v"(vb),"i"(d0*4096+ks*1024):"memory");
      asm volatile("ds_read_b64_tr_b16 %0,%1 offset:%c2":"=&v"(hi[ks]):"v"(vb),"i"(d0*4096+ks*1024+512):"memory");}
    asm volatile("s_waitcnt lgkmcnt(0)":::"memory");SBAR();
    #define PK(k) (bf16x8){lo[k][0],lo[k][1],lo[k][2],lo[k][3],hi[k][0],hi[k][1],hi[k][2],hi[k][3]}
    o[d0]=__builtin_amdgcn_mfma_f32_32x32x16_bf16(pa0,PK(0),o[d0],0,0,0);
    o[d0]=__builtin_amdgcn_mfma_f32_32x32x16_bf16(pa1,PK(1),o[d0],0,0,0);
    o[d0]=__builtin_amdgcn_mfma_f32_32x32x16_bf16(pa2,PK(2),o[d0],0,0,0);
    o[d0]=__builtin_amdgcn_mfma_f32_32x32x16_bf16(pa3,PK(3),o[d0],0,0,0);
    #undef PK
  }
}
__device__ __forceinline__ void head_norm_store(const bf16*stg,bf16*Ow,const bf16*gate,const float*g,int lane){
  const int ch=lane&7;
  const f32x4a g0=*(const f32x4a*)(g+ch*8), g1=*(const f32x4a*)(g+ch*8+4);
  #pragma unroll
  for(int i=0;i<4;++i){const int row=i*8+(lane>>3);
    const u32x4 v=*(const u32x4*)(stg+row*64+ch*8);
    float x[8]={bf_lo(v[0]),bf_hi(v[0]),bf_lo(v[1]),bf_hi(v[1]),bf_lo(v[2]),bf_hi(v[2]),bf_lo(v[3]),bf_hi(v[3])};
    float ss=0.f;
    #pragma unroll
    for(int j=0;j<8;++j)ss+=x[j]*x[j];
    ss+=__shfl_xor(ss,1);ss+=__shfl_xor(ss,2);ss+=__shfl_xor(ss,4);
    const float rs=1.0f/sqrtf(ss*(1.0f/64.0f)+1e-6f);
    float gm[8]={g0[0],g0[1],g0[2],g0[3],g1[0],g1[1],g1[2],g1[3]};
    if(gate){const u32x4 gv=*(const u32x4*)(gate+(long)row*DM+ch*8);
      float t[8]={bf_lo(gv[0]),bf_hi(gv[0]),bf_lo(gv[1]),bf_hi(gv[1]),bf_lo(gv[2]),bf_hi(gv[2]),bf_lo(gv[3]),bf_hi(gv[3])};
      #pragma unroll
      for(int j=0;j<8;++j)gm[j]*=__builtin_amdgcn_rcpf(1.0f+__builtin_amdgcn_exp2f(-LOG2E*t[j]));}
    u32x4 w;
    w[0]=cvtpk_s(x[0]*rs*gm[0],x[1]*rs*gm[1]);w[1]=cvtpk_s(x[2]*rs*gm[2],x[3]*rs*gm[3]);w[2]=cvtpk_s(x[4]*rs*gm[4],x[5]*rs*gm[5]);w[3]=cvtpk_s(x[6]*rs*gm[6],x[7]*rs*gm[7]);
    *(u32x4*)(Ow+(long)row*OD+ch*8)=w;}
}

__device__ __forceinline__ void fox_merge_rows(const float*__restrict__ PO,const float*__restrict__ PL,int nch,int wid,bf16*Ow,const bf16*gate,const float*g,int lane){
  const int ch=lane&7;
  const f32x4a g0=*(const f32x4a*)(g+ch*8), g1=*(const f32x4a*)(g+ch*8+4);
  #pragma unroll
  for(int i=0;i<4;++i){const int row=i*8+(lane>>3), rr=wid*QBLK+row;
    f32x4a a0={0.f,0.f,0.f,0.f},a1={0.f,0.f,0.f,0.f}; float l=0.f;
    for(int c=0;c<nch;++c){ const float*p=PO+(size_t)c*16384+(size_t)rr*64+ch*8; a0+=*(const f32x4a*)p; a1+=*(const f32x4a*)(p+4); l+=PL[c*256+rr]; }
    const float il=l>0.f?1.0f/l:0.f;
    float x[8]={a0[0]*il,a0[1]*il,a0[2]*il,a0[3]*il,a1[0]*il,a1[1]*il,a1[2]*il,a1[3]*il};
    float ss=0.f;
    #pragma unroll
    for(int j=0;j<8;++j)ss+=x[j]*x[j];
    ss+=__shfl_xor(ss,1);ss+=__shfl_xor(ss,2);ss+=__shfl_xor(ss,4);
    const float rs=1.0f/sqrtf(ss*(1.0f/64.0f)+1e-6f);
    float gm[8]={g0[0],g0[1],g0[2],g0[3],g1[0],g1[1],g1[2],g1[3]};
    {const u32x4 gv=*(const u32x4*)(gate+(long)row*DM+ch*8);
      float t[8]={bf_lo(gv[0]),bf_hi(gv[0]),bf_lo(gv[1]),bf_hi(gv[1]),bf_lo(gv[2]),bf_hi(gv[2]),bf_lo(gv[3]),bf_hi(gv[3])};
      #pragma unroll
      for(int j=0;j<8;++j)gm[j]*=__builtin_amdgcn_rcpf(1.0f+__builtin_amdgcn_exp2f(-LOG2E*t[j]));}
    u32x4 w;
    w[0]=cvtpk_s(x[0]*rs*gm[0],x[1]*rs*gm[1]);w[1]=cvtpk_s(x[2]*rs*gm[2],x[3]*rs*gm[3]);w[2]=cvtpk_s(x[4]*rs*gm[4],x[5]*rs*gm[5]);w[3]=cvtpk_s(x[6]*rs*gm[6],x[7]*rs*gm[7]);
    *(u32x4*)(Ow+(long)row*OD+ch*8)=w;}
}

__device__ __forceinline__ void fox_chunk(int b,int h,int qb,int ta,int ntl,bool last,bool fin,float kmaxh,const bf16*Q,const bf16*__restrict__ K,const bf16*__restrict__ V,const bf16*__restrict__ G,bf16*O,
                                          const float*__restrict__ floc,const float*__restrict__ ct,const float*__restrict__ gn,float*__restrict__ PO,float*__restrict__ PL,char*shm){
  int tid_=threadIdx.x; asm volatile("":"+v"(tid_));
  const int tid=tid_,lane=tid&63,r32=lane&31,hi=lane>>5; const int wid=__builtin_amdgcn_readfirstlane(tid>>6);
  const long rowbase=(long)b*SEQ; const int q0=qb*QB;
  const bf16*Qw=Q+(rowbase+q0+wid*QBLK)*DM+h*D;
  const bf16*Kh=K+(rowbase+(long)ta*KVBLK)*DM+h*D,*Vh=V+(rowbase+(long)ta*KVBLK)*DM+h*D;
  const unsigned lds0=(unsigned)(uintptr_t)shm;
  float*wsf=(float*)(shm+LDS_WS)+wid*64;
  const bf16*ksrc=Kh+(long)lane*DM+wid*8;
  const bf16*vsrc=Vh+(long)(16*(wid&3)+(lane>>2))*DM+(wid>>2)*32+(lane&3)*8;
  const unsigned kdst=lds0+LDS_K+wid*1024, vdst=lds0+LDS_V+wid*1024;
  #define DMA_K(t,slot) glds16(ksrc+(long)(t)*KVBLK*DM,(unsigned)__builtin_amdgcn_readfirstlane(kdst+(slot)))
  #define DMA_V(t,slot) glds16(vsrc+(long)(t)*KVBLK*DM,(unsigned)__builtin_amdgcn_readfirstlane(vdst+(slot)))
  const int vb0=(int)(lds0+LDS_V)+((lane>>4)&1)*32+(lane&3)*8+(4*hi+((lane&15)>>2))*64;
  const char*Kbase=shm+LDS_K; bf16x8 kf[8];
  const lds_cptr shm3=(lds_cptr)shm; const lds_cptr kp0=shm3+LDS_K+hi*1024+r32*16; const lds_cptr vp0=shm3+LDS_V+((lane>>4)&1)*32+(lane&3)*8+(4*hi+((lane&15)>>2))*64;
  const int NT=ntl;
  DMA_K(0,0);DMA_V(0,0);DMA_K(1,SLOTB);
  const float*pex=ct; float*tab=(float*)(shm+LDS_TAB);
  bf16x8 qr[4];
  #pragma unroll
  for(int d0=0;d0<4;++d0)qr[d0]=*reinterpret_cast<const bf16x8*>(&Qw[(long)r32*DM+d0*16+hi*8]);
  float flk[5]; const int s0k=ta*KVBLK+tid, sEnd=(ta+ntl)*KVBLK;
  #pragma unroll
  for(int i=0;i<5;++i)flk[i]=(s0k+512*i<sEnd)?floc[s0k+512*i]:0.f;
  const float flq=floc[q0+wid*QBLK+r32];
  const float pbase=pex[4*qb];
  #pragma unroll
  for(int i=0;i<5;++i){ const int s=s0k+512*i; if(s<sEnd)tab[s]=-(pex[s>>6]-pbase+flk[i])*LOG2E; }
  const float ft2=(pex[(q0+wid*QBLK+r32)>>6]-pbase+flq)*LOG2E;
  __syncthreads();
  const __attribute__((address_space(3))) float*tab3=(const __attribute__((address_space(3))) float*)(shm3+LDS_TAB)+ta*KVBLK+r32;
  #define KA(dst,t,half) do{ const float e_=tab3[(t)*64+(half)*32]; dst=hi?1.f:e_; }while(0)
  #define BIASMF(C,ka) __builtin_amdgcn_mfma_f32_32x32x2f32(ka,qa,C,0,0,0)
  float qa;
  { float qs=0.f;
    #pragma unroll
    for(int d0=0;d0<4;++d0){ const u32x4 w=__builtin_bit_cast(u32x4,qr[d0]);
      #pragma unroll
      for(int j=0;j<4;++j){ const float a0=bf_lo(w[j]),a1=bf_hi(w[j]); qs+=a0*a0+a1*a1; } }
    auto rr=__builtin_amdgcn_permlane32_swap(__float_as_uint(qs),__float_as_uint(qs),false,false); qs=__uint_as_float(rr[0])+__uint_as_float(rr[1]);
    const float mref=__builtin_fminf(sqrtf(qs)*kmaxh+0.25f,60.f);
    qa=hi?(ft2-mref):1.f; }
  float l_reg=0.f;f32x16 o[2];o[0]=f32x16{};o[1]=f32x16{};const f32x16 zero16=f32x16{};
  const int qrel=last?(wid*QBLK+r32):(1<<20);
  #define CMASK(P0,P1,t) do{int jb_=(t)-(NT-4); if(jb_>=0)cmask(P0,P1,jb_,qrel,hi);}while(0)
  #define START(P0,P1) do{ _Pragma("unroll") for(int r=0;r<16;++r)P0[r]=__builtin_amdgcn_exp2f(P0[r]); }while(0)
  #define RESC() do{}while(0)
  f32x16 pA0,pA1,pB0,pB1;
  int sl_prev=0,sl_cur=0,sl_next=SLOTB;
  #define ROT() do{sl_prev=sl_cur;sl_cur=sl_next;sl_next=(sl_next==(NSLOT-1)*SLOTB)?0:sl_next+SLOTB;}while(0)
  DMA_K(2,2*SLOTB);
  WAIT_BAR(3);
  { float ka0,ka1; KA(ka0,0,0); KA(ka1,0,1);
    qkt(pA0,pA1,Kbase,qr,zero16,r32,hi);
    pA0=BIASMF(pA0,ka0); pA1=BIASMF(pA1,ka1); }
  CMASK(pA0,pA1,0);
  START(pA0,pA1);
  _Pragma("unroll") for(int r=0;r<16;++r)pA1[r]=__builtin_amdgcn_exp2f(pA1[r]);
  WAIT_BAR(0);
  DMA_K(3,0);DMA_V(1,SLOTB);
  ROT();
  kload8(kf,kp0+sl_cur);
  WAIT_BAR(2);
  s16x4 vlo[8],vhi[8]; u32x4 pw0,pw1,pw2,pw3;
  #define PKW(P,B) cvtpk_s(P[B],P[B+1])
  #define PAF(k) __builtin_bit_cast(bf16x8,pw##k)
  #define VFR(i) (bf16x8){vlo[i][0],vlo[i][1],vlo[i][2],vlo[i][3],vhi[i][0],vhi[i][1],vhi[i][2],vhi[i][3]}
  #define PIN(x) asm volatile("":"+v"(x))
  #define MX3(a,b,c) __builtin_fmaxf(__builtin_fmaxf((a),(b)),(c))
  #define GAPA(MF,A0,A1,A2,A3,W0,W1,PW) do{ MF; sacc+=A0; sacc+=A1; sacc+=A2; sacc+=A3; PIN(sacc); W0; W1; PIN(PW); SBAR(); }while(0)
  #define EX(v) __builtin_amdgcn_exp2f(v)
  #define GAPB(MF,X,B) do{ MF; X[B]=EX(X[B]); X[B+1]=EX(X[B+1]); X[B+2]=EX(X[B+2]); X[B+3]=EX(X[B+3]); PIN(X); SBAR(); }while(0)
  #define VRD(i) do{ vlo[i]=vtr(vp_+(((i)>>2)*4096+((i)&3)*1024)); vhi[i]=vtr(vp_+(((i)>>2)*4096+((i)&3)*1024+512)); }while(0)
  #define KRD(G,j) do{ if(G){ kload2(kf,kp0+sl_next,j); SBAR(); } }while(0)
  #define STEP(C0,C1,P0,P1,t,GK,GV,GL) do{ SBAR(); \
    const lds_cptr vp_=vp0+sl_prev; float ka0_,ka1_; KA(ka0_,t,0); KA(ka1_,t,1); \
    VRD(0); SBAR(); float sacc=(P0[0]+P0[1]); \
    GAPA(C0=__builtin_amdgcn_mfma_f32_32x32x16_bf16(kf[0],qr[0],zero16,0,0,0), P0[2],P0[3],P0[4],P0[5],     pw0[0]=PKW(P0,0), pw0[1]=PKW(P0,2), pw0); \
    VRD(4); SBAR(); GAPA(C1=__builtin_amdgcn_mfma_f32_32x32x16_bf16(kf[1],qr[0],zero16,0,0,0), P0[6],P0[7],P0[8],P0[9],     pw0[2]=PKW(P0,4), pw0[3]=PKW(P0,6), pw0); \
    VRD(1); SBAR(); GAPA(C0=__builtin_amdgcn_mfma_f32_32x32x16_bf16(kf[2],qr[1],C0,0,0,0),   P0[10],P0[11],P0[12],P0[13], pw1[0]=PKW(P0,8), pw1[1]=PKW(P0,10), pw1); \
    VRD(5); SBAR(); GAPA(C1=__builtin_amdgcn_mfma_f32_32x32x16_bf16(kf[3],qr[1],C1,0,0,0),   P0[14],P0[15],P1[0],P1[1],   pw1[2]=PKW(P0,12),pw1[3]=PKW(P0,14), pw1); \
    VRD(2); SBAR(); GAPA(C0=__builtin_amdgcn_mfma_f32_32x32x16_bf16(kf[4],qr[2],C0,0,0,0),   P1[2],P1[3],P1[4],P1[5],     pw2[0]=PKW(P1,0), pw2[1]=PKW(P1,2), pw2); \
    VRD(6); SBAR(); GAPA(C1=__builtin_amdgcn_mfma_f32_32x32x16_bf16(kf[5],qr[2],C1,0,0,0),   P1[6],P1[7],P1[8],P1[9],     pw2[2]=PKW(P1,4), pw2[3]=PKW(P1,6), pw2); \
    VRD(3); SBAR(); GAPA(C0=__builtin_amdgcn_mfma_f32_32x32x16_bf16(kf[6],qr[3],C0,0,0,0),   P1[10],P1[11],P1[12],P1[13], pw3[0]=PKW(P1,8), pw3[1]=PKW(P1,10), pw3); \
    VRD(7); SBAR(); GAPA(C1=__builtin_amdgcn_mfma_f32_32x32x16_bf16(kf[7],qr[3],C1,0,0,0),   P1[14],P1[15],0.f,0.f,       pw3[2]=PKW(P1,12),pw3[3]=PKW(P1,14), pw3); \
    C0=BIASMF(C0,ka0_); C1=BIASMF(C1,ka1_); SBAR(); \
    l_reg+=sacc; \
    if(GK){DMA_K((t)+3,sl_cur);} if(GV){DMA_V((t)+1,sl_next);} \
    CMASK(C0,C1,t); \
    SBAR(); \
    GAPB(o[0]=__builtin_amdgcn_mfma_f32_32x32x16_bf16(PAF(0),VFR(0),o[0],0,0,0), C0,0); \
    GAPB(o[1]=__builtin_amdgcn_mfma_f32_32x32x16_bf16(PAF(0),VFR(4),o[1],0,0,0), C0,4); \
    KRD(GL,0); GAPB(o[0]=__builtin_amdgcn_mfma_f32_32x32x16_bf16(PAF(1),VFR(1),o[0],0,0,0), C0,8); \
    KRD(GL,1); GAPB(o[1]=__builtin_amdgcn_mfma_f32_32x32x16_bf16(PAF(1),VFR(5),o[1],0,0,0), C0,12); \
    KRD(GL,2); GAPB(o[0]=__builtin_amdgcn_mfma_f32_32x32x16_bf16(PAF(2),VFR(2),o[0],0,0,0), C1,0); \
    KRD(GL,3); GAPB(o[1]=__builtin_amdgcn_mfma_f32_32x32x16_bf16(PAF(2),VFR(6),o[1],0,0,0), C1,4); \
    GAPB(o[0]=__builtin_amdgcn_mfma_f32_32x32x16_bf16(PAF(3),VFR(3),o[0],0,0,0), C1,8); \
    GAPB(o[1]=__builtin_amdgcn_mfma_f32_32x32x16_bf16(PAF(3),VFR(7),o[1],0,0,0), C1,12); \
    }while(0)
  int t=1;
  #undef CMASK
  #define CMASK(P0,P1,t) do{}while(0)
  for(;t+5<NT;t+=2){
    STEP(pB0,pB1,pA0,pA1,t,true,true,true);     WAIT_BAR(2); RESC(); ROT();
    STEP(pA0,pA1,pB0,pB1,t+1,true,true,true);   WAIT_BAR(2); RESC(); ROT();
  }
  #undef CMASK
  #define CMASK(P0,P1,t) do{int jb_=(t)-(NT-4); if(jb_>=0)cmask(P0,P1,jb_,qrel,hi);}while(0)
  #define ENDW(tt) do{ if((tt)+3<NT){WAIT_BAR(2);} else if((tt)+2<NT){WAIT_BAR(1);} else {WAIT_BAR(0);} }while(0)
  for(;t+1<NT;t+=2){
    STEP(pB0,pB1,pA0,pA1,t,(t+3<NT),(t+1<NT),(t+1<NT));       ENDW(t);   RESC(); ROT();
    STEP(pA0,pA1,pB0,pB1,t+1,(t+4<NT),(t+2<NT),(t+2<NT));     ENDW(t+1); RESC(); ROT();
  }
  STEP(pB0,pB1,pA0,pA1,NT-1,false,false,false); RESC();
  { float sacc=pB0[0]+pB0[1]; _Pragma("unroll") for(int r=2;r<16;++r)sacc+=pB0[r]; _Pragma("unroll") for(int r=0;r<16;++r)sacc+=pB1[r]; l_reg+=sacc;
    pw0=(u32x4){PKW(pB0,0),PKW(pB0,2),PKW(pB0,4),PKW(pB0,6)};pw1=(u32x4){PKW(pB0,8),PKW(pB0,10),PKW(pB0,12),PKW(pB0,14)};pw2=(u32x4){PKW(pB1,0),PKW(pB1,2),PKW(pB1,4),PKW(pB1,6)};pw3=(u32x4){PKW(pB1,8),PKW(pB1,10),PKW(pB1,12),PKW(pB1,14)};
    SBAR(); pv(o,vb0+sl_cur,PAF(0),PAF(1),PAF(2),PAF(3)); }
  #undef PKW
  #undef PAF
  #undef VFR
  #undef PIN
  #undef MX3
  #undef GAPA
  #undef GAPB
  #undef EX
  #undef VRD
  #undef KRD
  #undef STEP
  #undef ENDW
  #undef KA
  #undef BIASMF
  {auto rr=__builtin_amdgcn_permlane32_swap(__float_as_uint(l_reg),__float_as_uint(l_reg),false,false);l_reg=__uint_as_float(rr[0])+__uint_as_float(rr[1]);}
  if(fin){
    if(hi==0)wsf[32+r32]=l_reg;asm volatile("s_waitcnt lgkmcnt(0)":::"memory");
    float rli[16];
    #pragma unroll
    for(int r=0;r<16;++r){const float lv=wsf[32+crow(r,hi)]; rli[r]=lv>0.f?__builtin_amdgcn_rcpf(lv):0.f;}
    bf16*stg=(bf16*)(shm+LDS_OST)+wid*2048;
    #pragma unroll
    for(int r=0;r<16;++r){const int orow=crow(r,hi);
      #pragma unroll
      for(int d0=0;d0<2;++d0)stg[orow*64+d0*32+r32]=__float2bfloat16(o[d0][r]*rli[r]);}
    asm volatile("s_waitcnt lgkmcnt(0)":::"memory");
    head_norm_store(stg,O+(rowbase+q0+wid*QBLK)*OD+h*D,G+(rowbase+q0+wid*QBLK)*DM+h*D,gn+h*D,lane);
  }else{
    float*po=PO+(size_t)(wid*QBLK)*64+r32;
    #pragma unroll
    for(int r=0;r<16;++r){const int orow=crow(r,hi);
      #pragma unroll
      for(int d0=0;d0<2;++d0)po[orow*64+d0*32]=o[d0][r];}
    if(hi==0)PL[wid*QBLK+r32]=l_reg;
  }
  asm volatile("s_waitcnt lgkmcnt(0)\n\ts_barrier":::"memory");
  #undef DMA_K
  #undef DMA_V
  #undef CMASK
  #undef START
  #undef RESC
  #undef ROT
}

__device__ __forceinline__ void sb_wave(int b,int h,int qw,const bf16*Q,const bf16*__restrict__ K,const bf16*__restrict__ V,bf16*O,const float*__restrict__ gn,char*slot,int lane_){
  int lane=lane_; asm volatile("":"+v"(lane));
  const int r32=lane&31,hi=lane>>5;
  const long rowbase=(long)b*SEQ;
  const bf16*Qw=Q+(rowbase+qw)*DM+h*D;
  const bf16*Kh=K+rowbase*DM+h*D,*Vh=V+rowbase*DM+h*D;
  const unsigned lds0=(unsigned)(uintptr_t)slot;
  const int vb0=(int)(lds0+8192)+((lane>>4)&1)*32+(lane&3)*8+(4*hi+((lane&15)>>2))*64;
  bf16x8 qr[4];
  #pragma unroll
  for(int d0=0;d0<4;++d0)qr[d0]=*reinterpret_cast<const bf16x8*>(&Qw[(long)r32*DM+d0*16+hi*8]);
  f32x16 o[2];o[0]=f32x16{};o[1]=f32x16{};
  const f32x16 zero=f32x16{};
  float carry=0.f;
  const int qabs=qw+r32;
  for(int j=(qw+30)>>6;j>=0;--j){
    asm volatile("s_waitcnt lgkmcnt(0)":::"memory");
    #pragma unroll
    for(int w8=0;w8<8;++w8)glds16(Kh+(long)(j*KVBLK+lane)*DM+w8*8,(unsigned)__builtin_amdgcn_readfirstlane(lds0+w8*1024));
    #pragma unroll
    for(int w8=0;w8<8;++w8)glds16(Vh+(long)(j*KVBLK+16*(w8&3)+(lane>>2))*DM+(w8>>2)*32+(lane&3)*8,(unsigned)__builtin_amdgcn_readfirstlane(lds0+8192+w8*1024));
    asm volatile("s_waitcnt vmcnt(0)":::"memory");
    f32x16 p0,p1;
    qkt(p0,p1,slot,qr,zero,r32,hi);
    const int kb=64*j+4*hi;
    float lk0[16],lk1[16];
    #pragma unroll
    for(int r=0;r<16;++r){
      const int kv=kb+(r&3)+8*(r>>2);
      { const float z=p0[r]; const float t=__builtin_amdgcn_logf(1.0f+__builtin_amdgcn_exp2f(-__builtin_fabsf(z))); const bool ok=kv<qabs;
        p0[r]=ok?(__builtin_fminf(z,0.f)-t):-INFINITY; lk0[r]=ok?(__builtin_fminf(-z,0.f)-t):0.f; }
      { const float z=p1[r]; const float t=__builtin_amdgcn_logf(1.0f+__builtin_amdgcn_exp2f(-__builtin_fabsf(z))); const bool ok=(kv+32)<qabs;
        p1[r]=ok?(__builtin_fminf(z,0.f)-t):-INFINITY; lk1[r]=ok?(__builtin_fminf(-z,0.f)-t):0.f; }
    }
    float gs[8],og[8];
    #pragma unroll
    for(int g=0;g<4;++g){gs[g]=(lk0[4*g]+lk0[4*g+1])+(lk0[4*g+2]+lk0[4*g+3]); gs[g+4]=(lk1[4*g]+lk1[4*g+1])+(lk1[4*g+2]+lk1[4*g+3]);}
    #pragma unroll
    for(int g=0;g<8;++g)og[g]=__shfl_xor(gs[g],32);
    float run=carry;
    #pragma unroll
    for(int g=7;g>=0;--g){
      const float base=run+(hi?0.f:og[g]);
      run+=gs[g]+og[g];
      if(g>=4){const int q=4*(g-4); const float l3=base,l2=l3+lk1[q+3],l1=l2+lk1[q+2],l0=l1+lk1[q+1];
        p1[q]=__builtin_amdgcn_exp2f(p1[q]+l0);p1[q+1]=__builtin_amdgcn_exp2f(p1[q+1]+l1);p1[q+2]=__builtin_amdgcn_exp2f(p1[q+2]+l2);p1[q+3]=__builtin_amdgcn_exp2f(p1[q+3]+l3);}
      else{const int q=4*g; const float l3=base,l2=l3+lk0[q+3],l1=l2+lk0[q+2],l0=l1+lk0[q+1];
        p0[q]=__builtin_amdgcn_exp2f(p0[q]+l0);p0[q+1]=__builtin_amdgcn_exp2f(p0[q+1]+l1);p0[q+2]=__builtin_amdgcn_exp2f(p0[q+2]+l2);p0[q+3]=__builtin_amdgcn_exp2f(p0[q+3]+l3);}
    }
    carry=run;
    u32x4 pw0,pw1,pw2,pw3;
    pw0=(u32x4){cvtpk_s(p0[0],p0[1]),cvtpk_s(p0[2],p0[3]),cvtpk_s(p0[4],p0[5]),cvtpk_s(p0[6],p0[7])};
    pw1=(u32x4){cvtpk_s(p0[8],p0[9]),cvtpk_s(p0[10],p0[11]),cvtpk_s(p0[12],p0[13]),cvtpk_s(p0[14],p0[15])};
    pw2=(u32x4){cvtpk_s(p1[0],p1[1]),cvtpk_s(p1[2],p1[3]),cvtpk_s(p1[4],p1[5]),cvtpk_s(p1[6],p1[7])};
    pw3=(u32x4){cvtpk_s(p1[8],p1[9]),cvtpk_s(p1[10],p1[11]),cvtpk_s(p1[12],p1[13]),cvtpk_s(p1[14],p1[15])};
    pv(o,vb0,__builtin_bit_cast(bf16x8,pw0),__builtin_bit_cast(bf16x8,pw1),__builtin_bit_cast(bf16x8,pw2),__builtin_bit_cast(bf16x8,pw3));
    if(__all(carry<-152.0f))break;
  }
  asm volatile("s_waitcnt lgkmcnt(0)":::"memory");
  { bf16*stg=(bf16*)slot;
    #pragma unroll
    for(int r=0;r<16;++r){const int orow=crow(r,hi);
      #pragma unroll
      for(int d0=0;d0<2;++d0)stg[orow*64+d0*32+r32]=__float2bfloat16(o[d0][r]);}
    asm volatile("s_waitcnt lgkmcnt(0)":::"memory");
    head_norm_store(stg,O+(rowbase+qw)*OD+h*D,nullptr,gn+h*D,lane); }
  asm volatile("s_waitcnt lgkmcnt(0)":::"memory");
}
#undef SBAR
#undef WAIT_BAR
}
namespace mk {
constexpr int NWAVES = 8;
constexpr int BATCH = 2, T = 8192, D = 1024, M = BATCH * T, NPROJ = 3584, NIN = 3592, NE = 16, DEPTH = 4, NMODC = 6144;
constexpr int PC_FQ = 0, PC_FK = 512, PC_FV = 1024, PC_FG = 1536, PC_SQ = 2048, PC_SK = 2560, PC_SV = 3072;
constexpr int MO_SHA = 0, MO_SCA = 1024, MO_GA = 2048, MO_SHF = 3072, MO_SCF = 4096, MO_GF = 5120;
constexpr float ALPHA = 1.6817928305074292f, LN_EPS = 1e-5f;
constexpr int HB_ROWS = 36864;

constexpr size_t MiB = 1u << 20;
constexpr size_t WS_CTL = 0, CTL_ZERO_BYTES = 1 * MiB;
constexpr size_t WS_MOD = 1 * MiB, WS_FLOC = 2 * MiB, WS_CT = 2 * MiB + 768 * 1024, WS_LIST = 3 * MiB, WS_TOKS = 4 * MiB, WS_TOKW = 4 * MiB + 256 * 1024;
constexpr size_t WS_WIN = 8 * MiB, WS_WOUT = 36 * MiB, WS_WGU = 44 * MiB, WS_WD = 300 * MiB;
constexpr size_t WS_UA = 428 * MiB, WS_PQ = 460 * MiB, WS_OB = 572 * MiB, WS_YB = 604 * MiB, WS_X1 = 668 * MiB, WS_U2 = 732 * MiB, WS_HB = 764 * MiB, WS_YD = 836 * MiB, WS_XDBG = 908 * MiB, WS_XB = 940 * MiB  ,
                 WS_PO = WS_YB  , WS_PL = WS_XDBG  , WS_END = 972 * MiB;
constexpr size_t WIN_L = (size_t)NPROJ * D * 2, WOUT_L = (size_t)D * D * 2, WGU_E = (size_t)2048 * D * 2, WGU_L = 16 * WGU_E, WD_E = (size_t)D * D * 2, WD_L = 16 * WD_E;
constexpr int CW_TMO = 0, CW_BAR = 4096, CW_CNT = 8192  , CW_CHK = 16384,
              CW_Q = 12288  , CW_FLAG = 12288 + 1024  ,
              CW_KMAX = 14336  ;

constexpr int RING_OFF = 0, RING_BYTES = 131072, LDSCTL_OFF = RING_BYTES, MISC_OFF = LDSCTL_OFF + 1024, ATT_TBL_OFF = MISC_OFF + 256  , LDS_BYTES = 147456;

#define GAS __attribute__((address_space(1)))
#define LAS __attribute__((address_space(3)))
typedef unsigned short bf16;
typedef unsigned v4u __attribute__((ext_vector_type(4)));
typedef float f32x4 __attribute__((ext_vector_type(4)));
typedef GAS unsigned gu32;
#define RLX_AGENT __ATOMIC_RELAXED, __HIP_MEMORY_SCOPE_AGENT
#define LDS_WAIT() asm volatile("s_waitcnt lgkmcnt(0)" ::: "memory")
__device__ __forceinline__ unsigned f2bf(float f) { unsigned u = __builtin_bit_cast(unsigned, f); return (u + 0x7fffu + ((u >> 16) & 1u)) >> 16; }
__device__ __forceinline__ unsigned pk2(float lo, float hi) { return f2bf(lo) | (f2bf(hi) << 16); }
__device__ __forceinline__ float bflo(unsigned w) { return __uint_as_float(w << 16); }
__device__ __forceinline__ float bfhi(unsigned w) { return __uint_as_float(w & 0xffff0000u); }
__device__ __forceinline__ f32x4 up4(unsigned long long p) { return (f32x4){bflo((unsigned)p), bfhi((unsigned)p), bflo((unsigned)(p >> 32)), bfhi((unsigned)(p >> 32))}; }
__device__ __forceinline__ unsigned long long pk4(const f32x4 v) { return (unsigned long long)pk2(v[0], v[1]) | ((unsigned long long)pk2(v[2], v[3]) << 32); }

#define XB_TMO      128
#define XB_XCNT(j)  (256  + 64 * (j))
#define XB_XSUB(j)  (1280 + 64 * (j))
#define XB_XGEN(j)  (2304 + 64 * (j))
#define XB_TOP      3328
#define XB_TOPGEN   3392
#define XCD_BAR_WORDS 3456
#define XB_SPIN_CAP (1u << 18)
__device__ __forceinline__ unsigned xb_ld(unsigned* p)              { return __hip_atomic_load(p, __ATOMIC_RELAXED, __HIP_MEMORY_SCOPE_AGENT); }
__device__ __forceinline__ unsigned xb_add(unsigned* p, unsigned v) { return __hip_atomic_fetch_add(p, v, __ATOMIC_RELAXED, __HIP_MEMORY_SCOPE_AGENT); }
__device__ __forceinline__ unsigned xb_xcc_id() { return (unsigned)__builtin_amdgcn_s_getreg((3 << 11) | 20) & 0xFu; }
#define XB_SPIN(cond, bar) do { unsigned _sp = 0; while (cond) { __builtin_amdgcn_s_sleep(1); \
    if ((++_sp & 255u) == 0u) { if (xb_ld(&(bar)[XB_TMO])) break; if (_sp > XB_SPIN_CAP) { atomicAdd(&(bar)[XB_TMO], 1u); break; } } } } while (0)
struct XcdBarrier { unsigned* bar; unsigned x; volatile LAS unsigned* st; };
__device__ __forceinline__ XcdBarrier xcd_barrier_post(unsigned* bar, volatile LAS unsigned* st) {
    XcdBarrier b; b.bar = bar; b.x = xb_xcc_id(); b.st = st;
    if (threadIdx.x == 0) (void)xb_add(&bar[XB_XCNT(b.x)], 1u);
    return b;
}
__device__ __forceinline__ void xcd_barrier_complete(unsigned* bar, unsigned x, unsigned& nloc, unsigned& nx) {
    const unsigned G = gridDim.x * gridDim.y * gridDim.z;
    unsigned sum, cnt, mine, sp = 0u;
    for (;;) {
        sum = 0u; cnt = 0u; mine = 0u;
#pragma unroll
        for (unsigned j = 0; j < 16; ++j) { const unsigned c = xb_ld(&bar[XB_XCNT(j)]); sum += c; cnt += (c > 0u) ? 1u : 0u; mine = (j == x) ? c : mine; }
        if (sum == G) break;
        __builtin_amdgcn_s_sleep(1);
        if ((++sp & 255u) == 0u) { if (xb_ld(&bar[XB_TMO])) break; if (sp > XB_SPIN_CAP) { atomicAdd(&bar[XB_TMO], 1u); break; } }
    }
    nloc = mine > 0u ? mine : 1u; nx = cnt > 0u ? cnt : 1u;
}
__device__ __forceinline__ void xcd_barrier(const XcdBarrier& b) {
    asm volatile("s_waitcnt vmcnt(0)" ::: "memory");
    __syncthreads();
    if (threadIdx.x == 0) {
        unsigned* bar = b.bar;
        __builtin_amdgcn_s_waitcnt(0);
        unsigned nloc = b.st[0], nx = b.st[1];
        if (nloc == 0u) { xcd_barrier_complete(bar, b.x, nloc, nx); b.st[0] = nloc; b.st[1] = nx; }
        const unsigned old = xb_add(&bar[XB_XSUB(b.x)], 1u);
        const unsigned gen = old / nloc;
        if (old + 1u == (gen + 1u) * nloc) {
            __builtin_amdgcn_fence(__ATOMIC_RELEASE, "agent");
            asm volatile("s_waitcnt vmcnt(0)" ::: "memory");
            const unsigned og = xb_add(&bar[XB_TOP], 1u);
            const unsigned tg = og / nx;
            if (og + 1u == (tg + 1u) * nx) xb_add(&bar[XB_TOPGEN], 1u);
            else XB_SPIN(xb_ld(&bar[XB_TOPGEN]) == tg, bar);
            __builtin_amdgcn_fence(__ATOMIC_ACQUIRE, "agent");
            xb_add(&bar[XB_XGEN(b.x)], 1u);
            asm volatile("s_waitcnt vmcnt(0)" ::: "memory");
        } else {
            XB_SPIN(xb_ld(&bar[XB_XGEN(b.x)]) == gen, bar);
            __builtin_amdgcn_fence(__ATOMIC_ACQUIRE, "agent");
            asm volatile("s_waitcnt vmcnt(0)" ::: "memory");
        }
    }
    __syncthreads();
}

struct Args {
    const float *x, *c, *w_mod, *b_mod, *w_in, *b_forget, *out_norm_g, *w_out, *ln1_g, *ln1_b, *w_router, *b_router, *w_gate, *w_up, *w_down, *ln2_g, *ln2_b;
    float* out; unsigned char* ws; int ph_lo, ph_hi, use_bar, pad;
};
#define AS4 __attribute__((address_space(4)))
__device__ __forceinline__ void load_args(Args& a) {
#if defined(__HIP_DEVICE_COMPILE__)
    const AS4 unsigned long long* k = (const AS4 unsigned long long*)__builtin_amdgcn_kernarg_segment_ptr(); asm volatile("" : "+s"(k));
#define MK_LDP(i, field) a.field = (decltype(a.field))(GAS void*)k[i]
    MK_LDP(0, x); MK_LDP(1, c); MK_LDP(2, w_mod); MK_LDP(3, b_mod); MK_LDP(4, w_in); MK_LDP(5, b_forget); MK_LDP(6, out_norm_g); MK_LDP(7, w_out); MK_LDP(8, ln1_g); MK_LDP(9, ln1_b);
    MK_LDP(10, w_router); MK_LDP(11, b_router); MK_LDP(12, w_gate); MK_LDP(13, w_up); MK_LDP(14, w_down); MK_LDP(15, ln2_g); MK_LDP(16, ln2_b); MK_LDP(17, out); MK_LDP(18, ws);
#undef MK_LDP
    a.ph_lo = 0; a.ph_hi = 0; a.use_bar = 0; a.pad = 0;
#endif
}
constexpr int N_PHASES = 2 + 8 * DEPTH;

__device__ __forceinline__ float wave_sum(float v) {
#pragma unroll
    for (int o = 1; o < 64; o <<= 1) v += __shfl_xor(v, o);
    return v;
}
__device__ __forceinline__ float sel_m(float a0, float a1, unsigned long long m) { float r; asm("v_cndmask_b32 %0, %1, %2, %3" : "=v"(r) : "v"(a0), "v"(a1), "s"(m)); return r; }
__device__ __forceinline__ float log_sigmoid_f(float z) { return fminf(z, 0.f) - log1pf(expf(-fabsf(z))); }

struct TrSrc { const float* W; int ldw; bf16* dst; };
__device__ __forceinline__ void tr_load(const TrSrc& s, int lane, f32x4 (&v)[8]) {
#pragma unroll
    for (int i = 0; i < 8; ++i) v[i] = *(const GAS f32x4*)(s.W + (size_t)(8 * i + (lane >> 3)) * s.ldw + 4 * (lane & 7));
}
__device__ __forceinline__ void tr_finish(const f32x4 (&v)[8], bf16* __restrict__ WT, LAS float* scr, int lane) {
#pragma unroll
    for (int i = 0; i < 8; ++i) { LAS float* d = scr + (8 * i + (lane >> 3)) * 33 + 4 * (lane & 7); d[0] = v[i][0]; d[1] = v[i][1]; d[2] = v[i][2]; d[3] = v[i][3]; }
    LDS_WAIT(); asm volatile("" ::: "memory");
    const int c = lane & 7;
#pragma unroll
    for (int j = 0; j < 4; ++j) { const int n = (lane >> 3) + 8 * j; const LAS float* s = scr + (8 * c) * 33 + n;
        v4u o; o.x = pk2(s[0 * 33], s[1 * 33]); o.y = pk2(s[2 * 33], s[3 * 33]); o.z = pk2(s[4 * 33], s[5 * 33]); o.w = pk2(s[6 * 33], s[7 * 33]);
        *(GAS v4u*)(WT + (size_t)n * D + 8 * c) = o; }
    LDS_WAIT(); asm volatile("" ::: "memory");
}
constexpr int IT_WINA = 1024, IT_WINB = 768, IT_WOUT = 512, IT_EXP = 1536, IT_LAYER = IT_WINA + IT_WINB + IT_WOUT + 16 * IT_EXP;
__device__ __forceinline__ TrSrc conv_addr(const Args& a, int l, int r) {
    unsigned char* ws = a.ws; TrSrc s;
    if (r < IT_WINA) { const int kb = r / 64, nb = r % 64; s.W = a.w_in + (size_t)l * D * NIN + (size_t)(64 * kb) * NIN + 32 * nb; s.ldw = NIN; s.dst = (bf16*)(ws + WS_WIN + l * WIN_L) + (size_t)(32 * nb) * D + 64 * kb; return s; }
    r -= IT_WINA;
    if (r < IT_WINB) { const int kb = r / 48, nb = r % 48; s.W = a.w_in + (size_t)l * D * NIN + (size_t)(64 * kb) * NIN + 2056 + 32 * nb; s.ldw = NIN; s.dst = (bf16*)(ws + WS_WIN + l * WIN_L) + (size_t)(2048 + 32 * nb) * D + 64 * kb; return s; }
    r -= IT_WINB;
    if (r < IT_WOUT) { const int kb = r / 32, nb = r % 32; s.W = a.w_out + (size_t)l * D * D + (size_t)(64 * kb) * D + 32 * nb; s.ldw = D; s.dst = (bf16*)(ws + WS_WOUT + l * WOUT_L) + (size_t)(32 * nb) * D + 64 * kb; return s; }
    r -= IT_WOUT;
    const int e = r / IT_EXP, q = r % IT_EXP, which = q / 512, qq = q % 512, kb = qq / 32, nb = qq % 32;
    const size_t so = ((size_t)(l * NE + e) * D + 64 * kb) * D + 32 * nb; s.ldw = D;
    if (which == 2) { s.W = a.w_down + so; s.dst = (bf16*)(ws + WS_WD + l * WD_L + e * WD_E) + (size_t)(32 * nb) * D + 64 * kb; }
    else { const int j0 = 32 * nb, row = 256 * (j0 >> 7) + (j0 & 127) + (which ? 128 : 0); s.W = (which ? a.w_up : a.w_gate) + so; s.dst = (bf16*)(ws + WS_WGU + l * WGU_L + e * WGU_E) + (size_t)row * D + 64 * kb; }
    return s;
}
__device__ __forceinline__ void p0_weights(LAS unsigned char* lds, int gw, int NGW, int wave, int lane) {
    Args a; load_args(a);
    LAS float* scr = (LAS float*)(lds + RING_OFF + 32768 + wave * 8704);
    f32x4 v[8]; TrSrc s = conv_addr(a, 0, gw); tr_load(s, lane, v);
#pragma unroll 1
    for (int it = gw; it < IT_LAYER; it += NGW) {
        f32x4 vn[8]; TrSrc sn = s; const bool more = it + NGW < IT_LAYER;
        if (more) { sn = conv_addr(a, 0, it + NGW); tr_load(sn, lane, vn); }
        tr_finish(v, s.dst, scr, lane);
        if (more) {
#pragma unroll
            for (int i = 0; i < 8; ++i) v[i] = vn[i];
            s = sn; }
    }
}
constexpr int Q_PER = 32, Q_CHUNKS = IT_LAYER / Q_PER, Q_CHUNKS_WIO = (IT_WINA + IT_WINB + IT_WOUT) / Q_PER;
__device__ __forceinline__ void conv_pull(LAS unsigned char* lds, int L, int upto, int flag_idx  , int tid, int wave, int lane) {
    if (L < 1 || L >= DEPTH) return;
    Args a; load_args(a);
    unsigned* ctl = (unsigned*)(a.ws + WS_CTL);
    unsigned* q = ctl + CW_Q + 64 * L;
    LAS float* scr = (LAS float*)(lds + RING_OFF + 32768 + wave * 8704);
    volatile LAS unsigned* bc = (volatile LAS unsigned*)(lds + LDSCTL_OFF + 960);
    for (;;) {
        __syncthreads();
        if (tid == 0) { unsigned c = 0xffffffffu;
            const bool stop = flag_idx >= 0 && __hip_atomic_load(ctl + CW_FLAG + 64 * flag_idx, RLX_AGENT) != 0u;
            if (!stop && __hip_atomic_load(q, RLX_AGENT) < (unsigned)upto) c = __hip_atomic_fetch_add(q, 1u, RLX_AGENT);
            *bc = c; }
        __syncthreads();
        const unsigned c = *bc;
        if (c >= (unsigned)Q_CHUNKS) break;
        { const int base = (int)c * Q_PER + wave; f32x4 v0[8], v1[8];
          TrSrc s0 = conv_addr(a, L, base), s1 = conv_addr(a, L, base + NWAVES), s2 = conv_addr(a, L, base + 2 * NWAVES), s3 = conv_addr(a, L, base + 3 * NWAVES);
          tr_load(s0, lane, v0); tr_load(s1, lane, v1); tr_finish(v0, s0.dst, scr, lane);
          tr_load(s2, lane, v0); tr_finish(v1, s1.dst, scr, lane);
          tr_load(s3, lane, v1); tr_finish(v0, s2.dst, scr, lane);
          tr_finish(v1, s3.dst, scr, lane); }
    }
}
__device__ __forceinline__ void gemm_tail(LAS unsigned char* lds, int total, int G, int c, int L1, int L2, int flag_idx, int tid, int wave, int lane) {
    const int i_last = (total - 1) / G; const bool late = (i_last * G + c) < total;
    if (late) { if (tid == 0) { Args a; load_args(a); __hip_atomic_store((unsigned*)(a.ws + WS_CTL) + CW_FLAG + 64 * flag_idx, 1u, RLX_AGENT); } }
#if !defined(NO_TAIL_PULL)
    else { conv_pull(lds, L1, Q_CHUNKS, flag_idx, tid, wave, lane); conv_pull(lds, L2, Q_CHUNKS, flag_idx, tid, wave, lane); }
#endif
}
__device__ __forceinline__ void p0_mod(LAS unsigned char* lds, int item, int tid, int wave, int lane) {
    Args a; load_args(a);
    LAS float* cond = (LAS float*)(lds + RING_OFF);
    LAS float* red = (LAS float*)(lds + RING_OFF + 8192);
    for (int i = tid; i < 2 * D; i += NWAVES * 64) { const float cv = a.c[i]; cond[i] = cv / (1.f + expf(-cv)); }
    __syncthreads();
    const int l = item / 24, n0 = (item % 24) * 256;
    const float* w = a.w_mod + (size_t)l * D * NMODC + n0 + 4 * lane;
    f32x4 a0 = {0.f, 0.f, 0.f, 0.f}, a1 = {0.f, 0.f, 0.f, 0.f};
#pragma unroll 8
    for (int k = wave * 128; k < wave * 128 + 128; ++k) { const f32x4 wv = *(const f32x4*)(w + (size_t)k * NMODC); a0 += wv * cond[k]; a1 += wv * cond[D + k]; }
    *(LAS f32x4*)(red + (wave * 2 + 0) * 256 + 4 * lane) = a0; *(LAS f32x4*)(red + (wave * 2 + 1) * 256 + 4 * lane) = a1;
    __syncthreads();
    { const int b = tid >> 8, n = tid & 255; float s = 0.f;
#pragma unroll
        for (int wv = 0; wv < 8; ++wv) s += red[(wv * 2 + b) * 256 + n];
        ((float*)(a.ws + WS_MOD))[(size_t)(l * 2 + b) * NMODC + n0 + n] = s + a.b_mod[l * NMODC + n0 + n]; }
    __syncthreads();
}

__device__ __forceinline__ void prep_load(LAS float* vsc, LAS float* vsh, const Args& a, int l, int b, int tid) {
    const float* mo = (const float*)(a.ws + WS_MOD) + (size_t)(l * 2 + b) * NMODC;
    for (int i = tid; i < D; i += NWAVES * 64) { vsc[i] = mo[MO_SCA + i]; vsh[i] = mo[MO_SHA + i]; }
}
__device__ __forceinline__ void prep_wf(const Args& a, int l, LAS float* wfT, int tid) {
    for (int i = tid; i < 8 * D; i += NWAVES * 64) { const int k = i >> 3, h = i & 7; wfT[h * D + k] = a.w_in[(size_t)l * D * NIN + (size_t)k * NIN + 2048 + h]; }
}
__device__ __forceinline__ void prep_row(const LAS float* vsc, const LAS float* vsh, const LAS float* wfT, const f32x4 (&x)[4], int m, int rl, const float* __restrict__ bfor, bf16* __restrict__ UA, LAS float* lfs, int lane) {
    float dots[8];
#pragma unroll
    for (int h = 0; h < 8; ++h) dots[h] = 0.f;
    GAS unsigned long long* o8 = (GAS unsigned long long*)(UA + (size_t)m * D) + lane;
#pragma unroll
    for (int j = 0; j < 4; ++j) { const f32x4 u = x[j] * (1.f + *(const LAS f32x4*)(vsc + 256 * j + 4 * lane)) + *(const LAS f32x4*)(vsh + 256 * j + 4 * lane);
        o8[64 * j] = (unsigned long long)pk2(u[0], u[1]) | ((unsigned long long)pk2(u[2], u[3]) << 32);
#pragma unroll
        for (int h = 0; h < 8; ++h) { const f32x4 w = *(const LAS f32x4*)(wfT + h * D + 256 * j + 4 * lane); dots[h] += (u[0] * w[0] + u[1] * w[1]) + (u[2] * w[2] + u[3] * w[3]); }
        __builtin_amdgcn_sched_barrier(0); }
#pragma unroll
    for (int s = 0; s < 3; ++s) { const int half = 4 >> s; const unsigned long long mk = s == 0 ? 0xAAAAAAAAAAAAAAAAull : s == 1 ? 0xCCCCCCCCCCCCCCCCull : 0xF0F0F0F0F0F0F0F0ull;
#pragma unroll
        for (int i = 0; i < half; ++i) { const float keep = sel_m(dots[i], dots[half + i], mk), send = sel_m(dots[half + i], dots[i], mk); dots[i] = keep + __shfl_xor(send, 1 << s); } }
    float tot = dots[0];
    tot += __shfl_xor(tot, 8); tot += __shfl_xor(tot, 16); tot += __shfl_xor(tot, 32);
    if (lane < 8) { const int h = 4 * (lane & 1) + 2 * ((lane >> 1) & 1) + ((lane >> 2) & 1); lfs[rl * 8 + h] = log_sigmoid_f(tot + bfor[h]); }
}
__device__ __forceinline__ void prep_scan(const Args& a, LAS float* lfs, int m0, int wave, int lane) {
    if (wave == 0) {
        const int b = m0 / T, t0 = m0 % T; float* floc = (float*)(a.ws + WS_FLOC); float* ct = (float*)(a.ws + WS_CT);
#pragma unroll
        for (int h = 0; h < 8; ++h) { float v = lfs[lane * 8 + h];
#pragma unroll
            for (int o = 1; o < 64; o <<= 1) { const float t = __shfl_up(v, o); if (lane >= o) v += t; }
            floc[(size_t)(b * 8 + h) * T + t0 + lane] = v; if (lane == 63) ct[(b * 8 + h) * 128 + (t0 >> 6)] = v; }
    }
}
__device__ __forceinline__ void phase_prep0(LAS unsigned char* lds, int G, int tid, int wave, int lane) {
    Args a; load_args(a);
    LAS float* lfs = (LAS float*)(lds + RING_OFF); LAS float* wfT = (LAS float*)(lds + RING_OFF + 4096); LAS float* vsc = (LAS float*)(lds + RING_OFF + 36864); LAS float* vsh = vsc + D;
    prep_wf(a, 0, wfT, tid);
    for (int rb = blockIdx.x; rb < M / 64; rb += G) {
        const int m0 = rb * 64, b = m0 / T;
        prep_load(vsc, vsh, a, 0, b, tid);
        __syncthreads();
#pragma unroll 1
        for (int i = 0; i < 8; ++i) { const int rl = wave * 8 + i, m = m0 + rl; f32x4 x[4];
#pragma unroll
            for (int j = 0; j < 4; ++j) x[j] = *(const f32x4*)(a.x + (size_t)m * D + 256 * j + 4 * lane);
            prep_row(vsc, vsh, wfT, x, m, rl, a.b_forget, (bf16*)(a.ws + WS_UA), lfs, lane); }
        __syncthreads();
        prep_scan(a, lfs, m0, wave, lane);
        __syncthreads();
    }
}

template <bool FIRST>
__device__ __forceinline__ void phase_ln1_router(int l, LAS unsigned char* lds, int G, int tid_, int wave, int lane_) {
    int tid = tid_, lane = lane_; asm volatile("" : "+v"(tid), "+v"(lane));
    Args a; load_args(a); const float* __restrict__ Xin = a.x; const bf16* __restrict__ XBin = (const bf16*)(a.ws + WS_XB);
    LAS float* wrT = (LAS float*)(lds + RING_OFF);
    LAS float* lgs = (LAS float*)(lds + RING_OFF + 65536);
    LAS int* rinfo = (LAS int*)(lds + RING_OFF + 65536 + 4096);
    LAS float* rw = (LAS float*)(lds + RING_OFF + 65536 + 4096 + 1024);
    LAS int* lcnt = (LAS int*)(lds + RING_OFF + 65536 + 4096 + 2048);
    LAS float* vga = (LAS float*)(lds + RING_OFF + 65536 + 8192); LAS float* vscf = vga + D; LAS float* vshf = vscf + D; LAS float* vlg = vshf + D; LAS float* vlb = vlg + D;
    for (int i = tid; i < NE * D; i += NWAVES * 64) { const int k = i >> 4, e = i & 15; wrT[e * D + k] = a.w_router[i]; }
    unsigned char* ws = a.ws;
    const bf16* YB = (const bf16*)(ws + WS_YB); bf16* X1 = (bf16*)(ws + WS_X1); bf16* U2 = (bf16*)(ws + WS_U2);
    int* list = (int*)(ws + WS_LIST); int* toks = (int*)(ws + WS_TOKS); float* tokw = (float*)(ws + WS_TOKW);
    unsigned* cntg = (unsigned*)(ws + WS_CTL) + CW_CNT + l * 16 * 64;
    for (int rb = blockIdx.x; rb < M / 64; rb += G) {
        const int m0 = rb * 64, b = m0 / T;
        if (tid < 32) lcnt[tid] = 0;
        const float* mo = (const float*)(ws + WS_MOD) + (size_t)(l * 2 + b) * NMODC;
        for (int i = tid; i < D; i += NWAVES * 64) { vga[i] = 1.f + mo[MO_GA + i]; vscf[i] = 1.f + mo[MO_SCF + i]; vshf[i] = mo[MO_SHF + i]; vlg[i] = a.ln1_g[l * D + i]; vlb[i] = a.ln1_b[l * D + i]; }
        __syncthreads();
        f32x4 bxi[2][4]; unsigned long long bx8[2][4], by8[2][4];
#define LN1_ISSUE(i, B) do { _Pragma("unroll") for (int j = 0; j < 4; ++j) { const size_t o_ = (size_t)(m0 + wave * 8 + (i)) * D + 256 * j + 4 * lane; \
            if constexpr (FIRST) bxi[B][j] = *(const GAS f32x4*)(Xin + o_); else bx8[B][j] = *(const GAS unsigned long long*)(XBin + o_); by8[B][j] = *(const GAS unsigned long long*)(YB + o_); } } while (0)
        LN1_ISSUE(0, 0);
#pragma unroll
        for (int i = 0; i < 8; ++i) {
            const int rl = wave * 8 + i, m = m0 + rl, B = i & 1; f32x4 v[4]; float s = 0.f;
            if (i + 1 < 8) { LN1_ISSUE(i + 1, (i + 1) & 1); }
            __builtin_amdgcn_sched_barrier(0);
#pragma unroll
            for (int j = 0; j < 4; ++j) { f32x4 xin; if constexpr (FIRST) xin = bxi[B][j]; else xin = up4(bx8[B][j]);
                v[j] = ALPHA * xin + *(const LAS f32x4*)(vga + 256 * j + 4 * lane) * up4(by8[B][j]); s += (v[j][0] + v[j][1]) + (v[j][2] + v[j][3]); }
            const float mu = wave_sum(s) * (1.f / D); float q = 0.f;
#pragma unroll
            for (int j = 0; j < 4; ++j) { v[j] = v[j] - mu; q += (v[j][0] * v[j][0] + v[j][1] * v[j][1]) + (v[j][2] * v[j][2] + v[j][3] * v[j][3]); }
            const float rstd = 1.f / sqrtf(wave_sum(q) * (1.f / D) + LN_EPS);
            float lgt[16];
#pragma unroll
            for (int e = 0; e < 16; ++e) lgt[e] = 0.f;
            GAS unsigned long long* o8 = (GAS unsigned long long*)(U2 + (size_t)m * D) + lane;
#pragma unroll
            for (int j = 0; j < 4; ++j) { const int kk = 256 * j + 4 * lane; const f32x4 x1 = v[j] * rstd * *(const LAS f32x4*)(vlg + kk) + *(const LAS f32x4*)(vlb + kk); *(GAS unsigned long long*)(X1 + (size_t)m * D + kk) = pk4(x1);
                const f32x4 u = x1 * *(const LAS f32x4*)(vscf + kk) + *(const LAS f32x4*)(vshf + kk);
                o8[64 * j] = (unsigned long long)pk2(u[0], u[1]) | ((unsigned long long)pk2(u[2], u[3]) << 32);
#pragma unroll
                for (int e = 0; e < 16; ++e) { const f32x4 w = *(const LAS f32x4*)(wrT + e * D + 256 * j + 4 * lane); lgt[e] += (u[0] * w[0] + u[1] * w[1]) + (u[2] * w[2] + u[3] * w[3]); if ((e & 3) == 3) __builtin_amdgcn_sched_barrier(0); } }
#pragma unroll
            for (int s2 = 0; s2 < 4; ++s2) { const int half = 8 >> s2; const unsigned long long mk = s2 == 0 ? 0xAAAAAAAAAAAAAAAAull : s2 == 1 ? 0xCCCCCCCCCCCCCCCCull : s2 == 2 ? 0xF0F0F0F0F0F0F0F0ull : 0xFF00FF00FF00FF00ull;
#pragma unroll
                for (int k = 0; k < half; ++k) { const float keep = sel_m(lgt[k], lgt[half + k], mk), send = sel_m(lgt[half + k], lgt[k], mk); lgt[k] = keep + __shfl_xor(send, 1 << s2); } }
            float tot = lgt[0]; tot += __shfl_xor(tot, 16); tot += __shfl_xor(tot, 32);
            if (lane < 16) { const int e = 8 * (lane & 1) + 4 * ((lane >> 1) & 1) + 2 * ((lane >> 2) & 1) + ((lane >> 3) & 1); lgs[rl * 16 + e] = tot; }
            __builtin_amdgcn_sched_barrier(0);
        }
#undef LN1_ISSUE
        LDS_WAIT();
        if (lane < 8) {
            const int rl = wave * 8 + lane; const LAS float* L = lgs + rl * 16;
            float mx = L[0];
            for (int e = 1; e < 16; ++e) mx = fmaxf(mx, L[e]);
            float sum = 0.f;
            for (int e = 0; e < 16; ++e) sum += expf(L[e] - mx);
            const float inv = 1.f / sum;
            int bg = 0; float bgs = -INFINITY;
            for (int g = 0; g < 4; ++g) { float t1 = -INFINITY, t2 = -INFINITY;
                for (int k = 0; k < 4; ++k) { const float sv = expf(L[g * 4 + k] - mx) * inv + a.b_router[g * 4 + k]; if (sv > t1) { t2 = t1; t1 = sv; } else if (sv > t2) t2 = sv; }
                const float gs = t1 + t2; if (gs > bgs) { bgs = gs; bg = g; } }
            int i0 = 0, i1 = 0; float t1 = -INFINITY, t2 = -INFINITY, p0 = 0.f, p1 = 0.f;
            for (int k = 0; k < 4; ++k) { const int e = bg * 4 + k; const float pr = expf(L[e] - mx) * inv, sv = pr + a.b_router[e];
                if (sv > t1) { t2 = t1; i1 = i0; p1 = p0; t1 = sv; i0 = e; p0 = pr; } else if (sv > t2) { t2 = sv; i1 = e; p1 = pr; } }
            const int r0 = atomicAdd((int*)&lcnt[i0], 1), r1 = atomicAdd((int*)&lcnt[i1], 1);
            rinfo[rl * 4 + 0] = i0; rinfo[rl * 4 + 1] = i1; rinfo[rl * 4 + 2] = r0; rinfo[rl * 4 + 3] = r1;
            const float wsum = p0 + p1; rw[rl * 2] = p0 / wsum; rw[rl * 2 + 1] = p1 / wsum;
        }
        __syncthreads();
        if (tid < 16) { const int n = lcnt[tid]; lcnt[16 + tid] = n ? (int)__hip_atomic_fetch_add(cntg + tid * 64, (unsigned)n, RLX_AGENT) : 0; }
        __syncthreads();
        if (tid < 64) { const int m = m0 + tid, e0 = rinfo[tid * 4], e1 = rinfo[tid * 4 + 1], q0 = lcnt[16 + e0] + rinfo[tid * 4 + 2], q1 = lcnt[16 + e1] + rinfo[tid * 4 + 3];
            list[(size_t)e0 * M + q0] = m; list[(size_t)e1 * M + q1] = m; toks[m * 2] = (e0 << 16) | q0; toks[m * 2 + 1] = (e1 << 16) | q1; tokw[m * 2] = rw[tid * 2]; tokw[m * 2 + 1] = rw[tid * 2 + 1]; }
        __syncthreads();
    }
}

__device__ __forceinline__ void moe_tables(const Args& a, int l, LAS int* tab, int tid) {
    if (tid == 0) { unsigned* cntg = (unsigned*)(a.ws + WS_CTL) + CW_CNT + l * 16 * 64; int run = 0;
        for (int e = 0; e < NE; ++e) { const int n = (int)__hip_atomic_load(cntg + e * 64, RLX_AGENT); tab[e] = n; tab[16 + e] = run; const int nb = (n + 255) >> 8; for (int k = 0; k < nb; ++k) tab[64 + run + k] = e; run += nb; }
        tab[32] = run; tab[33] = run; }
    __syncthreads();
}
struct MoeSched {
    const pg8::bf16_t* A; const unsigned char* W; const int* list; const LAS int* tab; int NT, G, vcu, K; size_t wstride;
    __device__ __forceinline__ bool next(int i, pg8::Unit& u) const {
        const int L = i * G + vcu; if (L >= tab[33] * NT) return false;
        const int rb = L / NT; u.pm = rb; u.pn = L - rb * NT; u.e = tab[64 + rb]; u.r0 = (rb - tab[16 + u.e]) * 256; u.nv = tab[u.e] - u.r0; return true;
    }
    __device__ __forceinline__ const char* aptr(const pg8::Unit& u) const { return (const char*)A + (size_t)u.pm * (size_t)256 * K * 2; }
    __device__ __forceinline__ const char* bptr(const pg8::Unit& u) const { return (const char*)W + (size_t)u.e * wstride + (size_t)u.pn * (size_t)256 * K * 2; }
    __device__ __forceinline__ void arows4(const pg8::Unit& u, int r, int (&t)[4]) const {
        const GAS int* lp = (const GAS int*)list + (size_t)u.e * M + u.r0; const int last = u.nv - 1;
#pragma unroll
        for (int k = 0; k < 4; ++k) { const int rr = r + 64 * k; t[k] = lp[rr < last ? rr : last]; }
    }
};
struct MoeSchedG : MoeSched {
    __device__ __forceinline__ const char* aptr(const pg8::Unit&) const { return (const char*)A; }
};

template <bool LAST>
__device__ __forceinline__ void phase_combine_ln2(int l, LAS unsigned char* lds, int G, int tid_, int wave, int lane_) {
    int tid = tid_, lane = lane_; asm volatile("" : "+v"(tid), "+v"(lane));
    Args a; load_args(a); float* __restrict__ Xout = a.out; bf16* __restrict__ XBout = (bf16*)(a.ws + WS_XB);
    LAS float* lfs = (LAS float*)(lds + RING_OFF); LAS float* wfT = (LAS float*)(lds + RING_OFF + 4096); LAS float* vsc = (LAS float*)(lds + RING_OFF + 36864); LAS float* vsh = vsc + D;
    LAS float* vgf = vsh + D; LAS float* vlg = vgf + D; LAS float* vlb = vlg + D;
    LAS int* tab = (LAS int*)(lds + LDSCTL_OFF);
    unsigned char* ws = a.ws;
    if (l + 1 < DEPTH) prep_wf(a, l + 1, wfT, tid);
    moe_tables(a, l, tab, tid);
    const bf16* X1 = (const bf16*)(ws + WS_X1); const bf16* YD = (const bf16*)(ws + WS_YD); const int* toks = (const int*)(ws + WS_TOKS); const float* tokw = (const float*)(ws + WS_TOKW);
    const bool nxt = (l + 1 < DEPTH);
    for (int rb = blockIdx.x; rb < M / 64; rb += G) {
        const int m0 = rb * 64, b = m0 / T;
        const float* mo = (const float*)(ws + WS_MOD) + (size_t)(l * 2 + b) * NMODC;
        __syncthreads();
        for (int i = tid; i < D; i += NWAVES * 64) { vgf[i] = 1.f + mo[MO_GF + i]; vlg[i] = a.ln2_g[l * D + i]; vlb[i] = a.ln2_b[l * D + i]; }
        if (nxt) prep_load(vsc, vsh, a, l + 1, b, tid);
        __syncthreads();
        const int mw = m0 + wave * 8;
        const int tkv = toks[mw * 2 + (lane & 15)]; const float twv = tokw[mw * 2 + (lane & 15)];
        unsigned long long bx[2][4], bya[2][4], byb[2][4];
#define CMB_ISSUE(i, B) do { const int s0_ = __builtin_amdgcn_readlane(tkv, 2 * (i)), s1_ = __builtin_amdgcn_readlane(tkv, 2 * (i) + 1); \
            const size_t r0_ = (size_t)(tab[16 + (s0_ >> 16)] * 256 + (s0_ & 0xffff)), r1_ = (size_t)(tab[16 + (s1_ >> 16)] * 256 + (s1_ & 0xffff)); \
            const GAS unsigned long long* y0_ = (const GAS unsigned long long*)(YD + r0_ * D) + lane; const GAS unsigned long long* y1_ = (const GAS unsigned long long*)(YD + r1_ * D) + lane; \
            _Pragma("unroll") for (int j = 0; j < 4; ++j) { bx[B][j] = *(const GAS unsigned long long*)(X1 + (size_t)(mw + (i)) * D + 256 * j + 4 * lane); bya[B][j] = y0_[64 * j]; byb[B][j] = y1_[64 * j]; } } while (0)
        CMB_ISSUE(0, 0);
#pragma unroll
        for (int i = 0; i < 8; ++i) {
            const int rl = wave * 8 + i, m = m0 + rl, B = i & 1;
            if (i + 1 < 8) { CMB_ISSUE(i + 1, (i + 1) & 1); }
            __builtin_amdgcn_sched_barrier(0);
            const float w0 = __builtin_bit_cast(float, __builtin_amdgcn_readlane(__builtin_bit_cast(int, twv), 2 * i)), w1 = __builtin_bit_cast(float, __builtin_amdgcn_readlane(__builtin_bit_cast(int, twv), 2 * i + 1));
            f32x4 v[4]; float s = 0.f;
#pragma unroll
            for (int j = 0; j < 4; ++j) { const unsigned long long p = bya[B][j], q = byb[B][j];
                const f32x4 ya = {bflo((unsigned)p), bfhi((unsigned)p), bflo((unsigned)(p >> 32)), bfhi((unsigned)(p >> 32))}, yb = {bflo((unsigned)q), bfhi((unsigned)q), bflo((unsigned)(q >> 32)), bfhi((unsigned)(q >> 32))};
                v[j] = ALPHA * up4(bx[B][j]) + *(const LAS f32x4*)(vgf + 256 * j + 4 * lane) * (w0 * ya + w1 * yb); s += (v[j][0] + v[j][1]) + (v[j][2] + v[j][3]); }
            const float mu = wave_sum(s) * (1.f / D); float q = 0.f;
#pragma unroll
            for (int j = 0; j < 4; ++j) { v[j] = v[j] - mu; q += (v[j][0] * v[j][0] + v[j][1] * v[j][1]) + (v[j][2] * v[j][2] + v[j][3] * v[j][3]); }
            const float rstd = 1.f / sqrtf(wave_sum(q) * (1.f / D) + LN_EPS);
#pragma unroll
            for (int j = 0; j < 4; ++j) { v[j] = v[j] * rstd * *(const LAS f32x4*)(vlg + 256 * j + 4 * lane) + *(const LAS f32x4*)(vlb + 256 * j + 4 * lane);
                if constexpr (LAST) *(f32x4*)(Xout + (size_t)m * D + 256 * j + 4 * lane) = v[j]; else *(GAS unsigned long long*)(XBout + (size_t)m * D + 256 * j + 4 * lane) = pk4(v[j]); }
            if (nxt) prep_row(vsc, vsh, wfT, v, m, rl, a.b_forget + (l + 1) * 8, (bf16*)(ws + WS_UA), lfs, lane);
            __builtin_amdgcn_sched_barrier(0);
        }
#undef CMB_ISSUE
        if (nxt) { __syncthreads(); prep_scan(a, lfs, m0, wave, lane); __syncthreads(); }
    }
}

struct AttTbl { LAS float* pexA  ; LAS unsigned short *nchv, *t0v, *offv, *rsz, *rk2u, *m2u; LAS int* wsum; };
__device__ __forceinline__ AttTbl att_tbl(LAS unsigned char* lds) { AttTbl t; t.pexA = (LAS float*)(lds + ATT_TBL_OFF); t.nchv = (LAS unsigned short*)(lds + ATT_TBL_OFF + 8448); t.t0v = t.nchv + 512; t.offv = t.t0v + 512; t.rsz = t.offv + 520; t.rk2u = t.rsz + 512; t.m2u = t.rk2u + 512;
    t.wsum = (LAS int*)(t.m2u + 512); return t; }
__device__ __forceinline__ int block_scan512(int v, LAS int* wsum, int wave, int lane, int& total) {
    int inc = v;
#pragma unroll
    for (int o = 1; o < 64; o <<= 1) { const int t_ = __shfl_up(inc, o); if (lane >= o) inc += t_; }
    __syncthreads();
    if (lane == 63) wsum[wave] = inc;
    __syncthreads();
    int off = 0, tot = 0;
#pragma unroll
    for (int w = 0; w < NWAVES; ++w) { const int s_ = wsum[w]; tot += s_; off += (w < wave) ? s_ : 0; }
    total = tot; return off + inc - v;
}
__device__ __forceinline__ void phase_attention(int l, LAS unsigned char* lds, char* lds_raw, int G, int vcu, int tid_, int wave, int lane_) {
    int tid = tid_, lane = lane_; asm volatile("" : "+v"(tid), "+v"(lane));
    Args a; load_args(a); unsigned char* ws = a.ws;
    const AttTbl t = att_tbl(lds);
    const float* CT = (const float*)(ws + WS_CT);
#if !defined(FOX_CH)
#define FOX_CH 32
#endif
#if !defined(FOX_SKIP_THR)
#define FOX_SKIP_THR -152.f
#endif
#pragma unroll
    for (int j = 0; j < 2; ++j) { const int bh = 2 * wave + j; const float c0v = CT[bh * 128 + 2 * lane], c1v = CT[bh * 128 + 2 * lane + 1]; const float s2 = c0v + c1v; float inc = s2;
#pragma unroll
        for (int o = 1; o < 64; o <<= 1) { const float t_ = __shfl_up(inc, o); if (lane >= o) inc += t_; }
        const float exc = inc - s2; t.pexA[bh * 132 + 2 * lane] = exc; t.pexA[bh * 132 + 2 * lane + 1] = exc + c0v; if (lane == 63) t.pexA[bh * 132 + 128] = inc; }
    __syncthreads();
    int my_nch, my_multi;
    { const int u = tid, bh = u & 15, qb = 31 - (u >> 4); const LAS float* px = t.pexA + bh * 132; const float base = px[4 * qb];
      int lo = 0, hi = 4 * qb;
      while (lo < hi) { const int mid = (lo + hi) >> 1; if ((base - px[mid + 1]) * attn_body::LOG2E <= FOX_SKIP_THR) lo = mid + 1; else hi = mid; }
      const int T0e = lo & ~1, nact = 4 * qb + 4 - T0e, nch = (nact + FOX_CH - 4) / FOX_CH;
      t.nchv[u] = (unsigned short)nch; t.t0v[u] = (unsigned short)T0e; t.rsz[u] = (unsigned short)(nact - FOX_CH * (nch - 1)); my_nch = nch; my_multi = nch > 1; }
    int NI, NM;
    { const int e = block_scan512(my_nch, t.wsum, wave, lane, NI); t.offv[tid] = (unsigned short)e; if (tid == 0) t.offv[512] = (unsigned short)NI; }
    { const int e = block_scan512(my_multi, t.wsum, wave, lane, NM); if (my_multi) t.m2u[e] = (unsigned short)tid; if (tid == 0) t.m2u[511] = (unsigned short)NM; }
    __syncthreads();
    { const int u = tid, mine = t.rsz[u]; int r = 0; const LAS unsigned* rz = (const LAS unsigned*)t.rsz;
      for (int v = 0; v < 256; ++v) { const unsigned w2 = rz[v]; const int o0 = (int)(w2 & 0xffffu), o1 = (int)(w2 >> 16); r += (o0 > mine || (o0 == mine && 2 * v < u)) ? 1 : 0; r += (o1 > mine || (o1 == mine && 2 * v + 1 < u)) ? 1 : 0; }
      t.rk2u[r] = (unsigned short)u; }
    __syncthreads();
    const int F = NI - 512, P = NI;
    const attn_body::bf16* PQ = (const attn_body::bf16*)(ws + WS_PQ); attn_body::bf16* OB = (attn_body::bf16*)(ws + WS_OB);
    const float* gn = a.out_norm_g + l * D;
    unsigned* kmx = (unsigned*)(ws + WS_CTL) + CW_KMAX + 64 * l;
    for (int q = 0; q * G < P; ++q) {
        const int p = q * G + ((q & 1) ? G - 1 - vcu : vcu); if (p >= P) continue;
        int ui, c;
        if (p < F) { int lo = 0, hi = 511; while (lo < hi) { const int mid = (lo + hi + 1) >> 1; if ((int)t.offv[mid] - mid <= p) lo = mid; else hi = mid - 1; } ui = lo; c = p - ((int)t.offv[lo] - lo); }
        else { ui = t.rk2u[p - F]; c = (int)t.nchv[ui] - 1; }
        const int u = __builtin_amdgcn_readfirstlane(ui); c = __builtin_amdgcn_readfirstlane(c);
        const int bh = u & 15, qb = 31 - (u >> 4), b = bh >> 3, h = bh & 7, NT = 4 * qb + 4;
        const int nch = __builtin_amdgcn_readfirstlane((int)t.nchv[u]), T0e = __builtin_amdgcn_readfirstlane((int)t.t0v[u]), k = __builtin_amdgcn_readfirstlane((int)t.offv[u]) + c;
        const int tb = NT - FOX_CH * c, ta = (c == nch - 1) ? T0e : tb - FOX_CH;
        const float k2 = __uint_as_float(__hip_atomic_load(kmx + bh * 2, RLX_AGENT)) + __uint_as_float(__hip_atomic_load(kmx + bh * 2 + 1, RLX_AGENT));
        const float kmaxh = sqrtf(k2) * 1.01f;
        attn_body::fox_chunk(b, h, qb, ta, tb - ta, c == 0, nch == 1, kmaxh, PQ + PC_FQ, PQ + PC_FK, PQ + PC_FV, PQ + PC_FG, OB,
                             (const float*)(ws + WS_FLOC) + (size_t)bh * T, (const float*)(lds_raw + ATT_TBL_OFF) + bh * 132, gn, (float*)(ws + WS_PO) + (size_t)k * 16384, (float*)(ws + WS_PL) + (size_t)k * 256, lds_raw + RING_OFF);
    }
    for (int v = vcu; v < 256; v += G) {
        const int bh = v >> 4, s = v & 15, b = bh >> 3, h = bh & 7;
        for (int k = 0; k < 2; ++k) { const int qb = (k & 1) ? 31 - s : s;
            attn_body::sb_wave(b, h, qb * 256 + wave * 32, PQ + PC_SQ, PQ + PC_SK, PQ + PC_SV, OB + 512, gn + 512, lds_raw + RING_OFF + wave * 16384, lane); }
        __syncthreads();
    }
}
__device__ __forceinline__ void phase_fox_merge(int l, LAS unsigned char* lds, int G, int vcu, int tid_, int wave, int lane_) {
    int tid = tid_, lane = lane_; asm volatile("" : "+v"(tid), "+v"(lane));
    Args a; load_args(a); unsigned char* ws = a.ws;
    const AttTbl t = att_tbl(lds);
    const attn_body::bf16* PQ = (const attn_body::bf16*)(ws + WS_PQ); attn_body::bf16* OB = (attn_body::bf16*)(ws + WS_OB);
    const float* gn = a.out_norm_g + l * D;
    const int NM = t.m2u[511];
    for (int j = vcu; j < NM; j += G) {
        const int u = __builtin_amdgcn_readfirstlane((int)t.m2u[j]), nch = __builtin_amdgcn_readfirstlane((int)t.nchv[u]), off = __builtin_amdgcn_readfirstlane((int)t.offv[u]);
        const int bh = u & 15, qb = 31 - (u >> 4), b = bh >> 3, h = bh & 7; const long row0 = (long)b * T + qb * 256 + wave * 32;
        attn_body::fox_merge_rows((const float*)(ws + WS_PO) + (size_t)off * 16384, (const float*)(ws + WS_PL) + (size_t)off * 256, nch, wave,
                                  OB + row0 * D + h * 64, PQ + PC_FG + row0 * NPROJ + h * 64, gn + h * 64, lane);
    }
}

#ifndef FOX_THRL
#define FOX_THRL 96
#endif
#ifndef FOX_VAR
#define FOX_VAR 0
#endif
#ifndef REP_INPROJ
#define REP_INPROJ 1
#endif
#ifndef REP_FOX
#define REP_FOX 1
#endif
#ifndef REP_SB
#define REP_SB 1
#endif
#ifndef REP_OUTPROJ
#define REP_OUTPROJ 1
#endif
#ifndef REP_GATEUP
#define REP_GATEUP 1
#endif
#ifndef REP_DOWN
#define REP_DOWN 1
#endif
#ifndef REP_COMB
#define REP_COMB 1
#endif
#ifndef REP_P0
#define REP_P0 1
#endif
#ifndef REP_P1
#define REP_P1 1
#endif

__global__ void __launch_bounds__(NWAVES * 64, 2) mk_fwd(Args args) {
    extern __shared__ __attribute__((aligned(16))) unsigned char lds_raw[];
    LAS unsigned char* lds = (LAS unsigned char*)lds_raw;
    volatile LAS unsigned* MISC = (volatile LAS unsigned*)(lds + MISC_OFF);
    const int tid = threadIdx.x, lane = tid & 63, wave = __builtin_amdgcn_readfirstlane(tid >> 6);
    const int G = gridDim.x; int vcu; { const int bx = blockIdx.x; vcu = (G % 8 == 0) ? (bx % 8) * (G / 8) + bx / 8 : bx; }
    for (int u = tid; u < (LDS_BYTES - LDSCTL_OFF) / 4; u += NWAVES * 64) ((LAS unsigned*)(lds + LDSCTL_OFF))[u] = 0u;
    __syncthreads();
    XcdBarrier bar; bar.bar = (unsigned*)(args.ws + WS_CTL) + CW_BAR; bar.x = 0; bar.st = nullptr;
    if (args.use_bar) bar = xcd_barrier_post((unsigned*)(args.ws + WS_CTL) + CW_BAR, MISC + 8);
    const int lo = args.ph_lo, hi = args.ph_hi;
#define IN(k) (lo <= (k) && (k) < hi)
#if defined(MK_STAMP)
#define STAMP(k) do { if (blockIdx.x == 0 && tid == 0) ((unsigned long long*)(args.ws + WS_CTL + 512 * 1024))[(k) + 1] = __builtin_amdgcn_s_memrealtime(); } while (0)
#else
#define STAMP(k) do { } while (0)
#endif
#define SEAM(k) do { if (IN(k) && IN((k) + 1)) xcd_barrier(bar); STAMP(k); } while (0)
    STAMP(-1);

    if (IN(0)) for (int rp_ = 0; rp_ < REP_P0; ++rp_) {
        for (int it = (int)blockIdx.x; it < DEPTH * 24; it += G) p0_mod(lds, it, tid, wave, lane);
        p0_weights(lds, vcu * NWAVES + wave, G * NWAVES, wave, lane);
    }
    SEAM(0);
    if (IN(1)) for (int rp_ = 0; rp_ < REP_P1; ++rp_) { phase_prep0(lds, G, tid, wave, lane); __syncthreads(); }
    SEAM(1);

#define MK_LAYER(l) { \
        const int pb = 2 + 8 * l; \
        if (IN(pb + 0)) { \
            Args A_; load_args(A_); unsigned char* ws = A_.ws; \
            pg8::DenseSched S; S.init((const pg8::bf16_t*)(ws + WS_UA), (const pg8::bf16_t*)(ws + WS_WIN + l * WIN_L), M, NPROJ, D, G, (int)blockIdx.x); \
            pg8::EpiBf16S E{(pg8::bf16_t*)(ws + WS_PQ), NPROJ, 0x303u, attn_body::C2, (unsigned*)(ws + WS_CTL) + CW_KMAX + 64 * l}; \
            for (int rp_ = 0; rp_ < REP_INPROJ; ++rp_) pg8::gemm_phase<pg8::EpiBf16S, pg8::DenseSched, true, false>(lds + RING_OFF, D, S, E); \
            gemm_tail(lds, (M / 256) * (NPROJ / 256), G, (int)blockIdx.x, l, l + 1, 4 * l + 0, tid, wave, lane); \
        } \
        SEAM(pb + 0); \
        if (IN(pb + 1)) phase_attention(l, lds, (char*)lds_raw, G, vcu, tid, wave, lane); \
        SEAM(pb + 1); \
        if (IN(pb + 2)) phase_fox_merge(l, lds, G, vcu, tid, wave, lane); \
        SEAM(pb + 2); \
        if (IN(pb + 3)) { \
            Args A_; load_args(A_); unsigned char* ws = A_.ws; \
            pg8::DenseSched S; S.init((const pg8::bf16_t*)(ws + WS_OB), (const pg8::bf16_t*)(ws + WS_WOUT + l * WOUT_L), M, D, D, G, (int)blockIdx.x); \
            pg8::EpiBf16S E{(pg8::bf16_t*)(ws + WS_YB), D, 0u, 1.f, nullptr}; \
            for (int rp_ = 0; rp_ < REP_OUTPROJ; ++rp_) pg8::gemm_phase<pg8::EpiBf16S, pg8::DenseSched, true, false>(lds + RING_OFF, D, S, E); \
        } \
        SEAM(pb + 3); \
        if (IN(pb + 4)) { conv_pull(lds, l, Q_CHUNKS, -1, tid, wave, lane); phase_ln1_router<(l) == 0>(l, lds, G, tid, wave, lane); } \
        SEAM(pb + 4); \
        if (IN(pb + 5)) { \
            Args A_; load_args(A_); unsigned char* ws = A_.ws; \
            LAS int* tab = (LAS int*)(lds + LDSCTL_OFF); moe_tables(A_, l, tab, tid); \
            MoeSchedG S; S.A = (const pg8::bf16_t*)(ws + WS_U2); S.W = ws + WS_WGU + l * WGU_L; S.list = (const int*)(ws + WS_LIST); S.tab = tab; S.NT = 8; S.G = G; S.vcu = vcu; S.K = D; S.wstride = WGU_E; \
            pg8::EpiGateUp E{(pg8::bf16_t*)(ws + WS_HB), D}; \
            for (int rp_ = 0; rp_ < REP_GATEUP; ++rp_) pg8::gemm_phase<pg8::EpiGateUp, MoeSchedG, true, true>(lds + RING_OFF, D, S, E); \
            gemm_tail(lds, tab[33] * 8, G, vcu, l + 1, 0, 4 * l + 1, tid, wave, lane); \
        } \
        SEAM(pb + 5); \
        if (IN(pb + 6)) { \
            Args A_; load_args(A_); unsigned char* ws = A_.ws; \
            LAS int* tab = (LAS int*)(lds + LDSCTL_OFF); moe_tables(A_, l, tab, tid); \
            MoeSched S; S.A = (const pg8::bf16_t*)(ws + WS_HB); S.W = ws + WS_WD + l * WD_L; S.list = nullptr; S.tab = tab; S.NT = 4; S.G = G; S.vcu = vcu; S.K = D; S.wstride = WD_E; \
            pg8::EpiBf16S E{(pg8::bf16_t*)(ws + WS_YD), D, 0u, 1.f, nullptr}; \
            for (int rp_ = 0; rp_ < REP_DOWN; ++rp_) pg8::gemm_phase<pg8::EpiBf16S, MoeSched, true, false>(lds + RING_OFF, D, S, E); \
            gemm_tail(lds, tab[33] * 4, G, vcu, l + 1, 0, 4 * l + 2, tid, wave, lane); \
        } \
        SEAM(pb + 6); \
        if (IN(pb + 7)) { conv_pull(lds, l + 1, Q_CHUNKS_WIO, -1, tid, wave, lane); for (int rp_ = 0; rp_ < REP_COMB; ++rp_) { phase_combine_ln2<(l) == DEPTH - 1>(l, lds, G, tid, wave, lane); __syncthreads(); } } \
        SEAM(pb + 7); \
    }
    MK_LAYER(0) MK_LAYER(1) MK_LAYER(2) MK_LAYER(3)
#undef MK_LAYER
#if defined(MK_STAMP)
    {
        xcd_barrier(bar);
        const unsigned long long* ts = (const unsigned long long*)(args.ws + WS_CTL + 512 * 1024);
        const float da = (float)(ts[STAMP_A + 1] - ts[STAMP_A]) * 1e-5f, db = (float)(ts[STAMP_B + 1] - ts[STAMP_B]) * 1e-2f;
        const float d1 = sqrtf(da);
        for (size_t i = (size_t)blockIdx.x * 512 + tid; i < (size_t)M * D / 4; i += (size_t)G * 512) { f32x4 v = ((f32x4*)args.out)[i]; v = v + d1; ((f32x4*)args.out)[i] = v; }
        __syncthreads();
        if (blockIdx.x == 0 && tid == 0) args.out[0] += db;
    }
#endif
#undef IN
#undef SEAM
}

static int g_grid = 0;
static bool mk_setup() {
    if (g_grid) return g_grid > 0;
    int dev = 0, cus = 0, per_cu = 0;
    if (hipGetDevice(&dev) != hipSuccess || hipDeviceGetAttribute(&cus, hipDeviceAttributeMultiprocessorCount, dev) != hipSuccess) { g_grid = -1; return false; }
    if (hipFuncSetAttribute((const void*)mk_fwd, hipFuncAttributeMaxDynamicSharedMemorySize, LDS_BYTES) != hipSuccess) { fprintf(stderr, "mk: hipFuncSetAttribute failed\n"); g_grid = -1; return false; }
    if (hipOccupancyMaxActiveBlocksPerMultiprocessor(&per_cu, (const void*)mk_fwd, NWAVES * 64, LDS_BYTES) != hipSuccess || per_cu < 1) fprintf(stderr, "mk: occupancy query reports %d\n", per_cu);
    (void)hipGetLastError();
    g_grid = cus;
    return true;
}
static void fill_args(Args& a, void* const* d_in, float* out, void* d_ws) {
    const float** f = (const float**)&a;
    for (int i = 0; i < 17; ++i) f[i] = (const float*)d_in[i];
    a.out = out; a.ws = (unsigned char*)d_ws; a.pad = 0;
}
static void launch_range(Args a, int lo, int hi, int use_bar, hipStream_t stream) {
    a.ph_lo = lo; a.ph_hi = hi; a.use_bar = use_bar;
    hipLaunchKernelGGL(mk_fwd, dim3(g_grid), dim3(NWAVES * 64), LDS_BYTES, stream, a);
}
}
extern "C" void kernel_launch(void* const* d_in, const int* in_sizes, int n_in, void* d_out, int out_size, void* d_ws, size_t ws_size, hipStream_t stream) {
    if (!mk::mk_setup()) return;
    if (ws_size < mk::WS_END) { fprintf(stderr, "ws too small\n"); return; }
    (void)hipMemsetAsync((char*)d_ws + mk::WS_CTL, 0, mk::CTL_ZERO_BYTES, stream);
    mk::Args a{}; mk::fill_args(a, d_in, (float*)d_out, d_ws);
    mk::launch_range(a, 0, mk::N_PHASES, 1, stream);
}
```
